# Optimizing an MI355X kernel written in HIP

```python
import math
import jax, jax.numpy as jnp
from jax import lax
import numpy as np

D_MODEL = 2048
BATCH = 2
SEQ = 4096
DEPTH = 2

SSM_WIDTH = 1024
SSM_GROUP = 16
SSM_GROUPS = SSM_WIDTH // SSM_GROUP
SSM_STATE = 64
DT_MIN = 1e-3
DT_MAX = 1e-1
HEAD_DIM = 64
N_Q_HEADS = 16
N_KV_HEADS = 4
Q_PER_KV = N_Q_HEADS // N_KV_HEADS
WINDOW = 128
ATTN_WIDTH = N_Q_HEADS * HEAD_DIM
KV_WIDTH = N_KV_HEADS * HEAD_DIM
SGU_WIDTH = 1024
SGU_HEADS = 8
SGU_HEAD_DIM = SGU_WIDTH // SGU_HEADS
SGU_CHUNK = 128
N_BRANCH = 3
BRANCH_WIDTH = 1024
PEER_HEADS = 8
PEER_QDIM = 256
PEER_HALF = PEER_QDIM // 2
N_KEYS = 128
N_EXPERTS = N_KEYS * N_KEYS
PEER_TOPK = 16
PEER_TOKEN_CHUNK = 128
EPS = 1e-6

SPLIT_POINTS = (
    SSM_WIDTH,
    SSM_WIDTH + ATTN_WIDTH,
    SSM_WIDTH + ATTN_WIDTH + KV_WIDTH,
    SSM_WIDTH + ATTN_WIDTH + 2 * KV_WIDTH,
    SSM_WIDTH + ATTN_WIDTH + 2 * KV_WIDTH + 2 * SGU_WIDTH,
)
IN_COLS = SPLIT_POINTS[-1] + N_BRANCH * D_MODEL

kernel_name = 'hybrid_s5_swa_sgu_peer_trunk'


def rms_norm(x, g):
    xf = x.astype(jnp.float32)
    y = xf * lax.rsqrt(jnp.mean(xf * xf, axis=-1, keepdims=True) + EPS)
    return (y * g.astype(jnp.float32)).astype(x.dtype)


def layer_norm(x, g, b):
    xf = x.astype(jnp.float32)
    mu = jnp.mean(xf, axis=-1, keepdims=True)
    xc = xf - mu
    y = xc * lax.rsqrt(jnp.mean(xc * xc, axis=-1, keepdims=True) + EPS)
    return (y * g.astype(jnp.float32) + b.astype(jnp.float32)).astype(x.dtype)


def s5_branch(u, a_re, a_im, b_re, b_im, c_re, c_im, d, log_dt, w_glu, b_glu):
    bsz, L = u.shape[0], u.shape[1]
    f32 = jnp.float32
    uf = u.astype(f32)
    ug = uf.reshape(bsz, L, SSM_GROUPS, SSM_GROUP)
    lam = lax.complex(a_re.astype(f32), a_im.astype(f32))
    dt = jnp.exp(log_dt.astype(f32))[:, None]
    a_bar = jnp.exp(lam * dt)
    b_c = lax.complex(b_re.astype(f32), b_im.astype(f32))
    b_bar = ((a_bar - 1.0) / lam)[..., None] * b_c
    bu = jnp.einsum('bsgh,gph->bsgp', ug, b_bar)
    a_seq = jnp.broadcast_to(a_bar[None, None], (1, L, SSM_GROUPS, SSM_STATE))

    def combine(e1, e2):
        a1, s1 = e1
        a2, s2 = e2
        return a2 * a1, a2 * s1 + s2

    _, states = lax.associative_scan(combine, (a_seq, bu), axis=1)
    y = (jnp.einsum('ghp,bsgp->bsgh', c_re.astype(f32), states.real)
         - jnp.einsum('ghp,bsgp->bsgh', c_im.astype(f32), states.imag))
    y = y.reshape(bsz, L, SSM_WIDTH) + d.astype(f32) * uf
    y = jax.nn.gelu(y, approximate=False)
    y = y * jax.nn.sigmoid(y @ w_glu.astype(f32) + b_glu.astype(f32))
    return y.astype(u.dtype)


def sliding_window_attention(q, k, v, q_g, k_g, sinks):
    bsz, L = q.shape[0], q.shape[1]
    nb = L // WINDOW
    f32 = jnp.float32
    q = rms_norm(q.reshape(bsz, L, N_KV_HEADS, Q_PER_KV, HEAD_DIM), q_g)
    k = rms_norm(k.reshape(bsz, L, N_KV_HEADS, HEAD_DIM), k_g)
    v = v.reshape(bsz, L, N_KV_HEADS, HEAD_DIM)
    qb = q.reshape(bsz, nb, WINDOW, N_KV_HEADS, Q_PER_KV, HEAD_DIM).astype(f32)
    kb = k.reshape(bsz, nb, WINDOW, N_KV_HEADS, HEAD_DIM).astype(f32)
    vb = v.reshape(bsz, nb, WINDOW, N_KV_HEADS, HEAD_DIM).astype(f32)
    pad = jnp.zeros_like(kb[:, :1])
    k_band = jnp.concatenate([jnp.concatenate([pad, kb[:, :-1]], axis=1), kb], axis=2)
    v_band = jnp.concatenate([jnp.concatenate([pad, vb[:, :-1]], axis=1), vb], axis=2)
    scores = jnp.einsum('bnqkgd,bnskd->bnkgqs', qb, k_band) * (HEAD_DIM ** -0.5)
    qpos = jnp.arange(WINDOW)[:, None] + WINDOW
    kpos = jnp.arange(2 * WINDOW)[None, :]
    diff = qpos - kpos
    valid = (diff >= 0) & (diff < WINDOW)
    first = jnp.arange(nb)[:, None, None] == 0
    mask = jnp.where(first, valid[None] & (kpos >= WINDOW)[None], valid[None])
    scores = jnp.where(mask[None, :, None, None], scores, -1e30)
    sink = jnp.broadcast_to(sinks.astype(f32).reshape(1, 1, N_KV_HEADS, Q_PER_KV, 1, 1),
                            scores.shape[:-1] + (1,))
    probs = jax.nn.softmax(jnp.concatenate([scores, sink], axis=-1), axis=-1)[..., :-1]
    out = jnp.einsum('bnkgqs,bnskd->bnqkgd', probs, v_band)
    return out.reshape(bsz, L, ATTN_WIDTH).astype(q.dtype)


def spatial_gating(z, ln_g, ln_b, w_s, b_s):
    bsz, L = z.shape[0], z.shape[1]
    nc = L // SGU_CHUNK
    z = jax.nn.gelu(z, approximate=False)
    u, v = jnp.split(z, 2, axis=-1)
    v = layer_norm(v, ln_g, ln_b)
    vb = v.reshape(bsz, nc, SGU_CHUNK, SGU_HEADS, SGU_HEAD_DIM)
    w = jnp.tril(w_s)
    mixed = jnp.einsum('hts,bnshc->bnthc', w, vb) + b_s.T[None, None, :, :, None]
    return u * mixed.reshape(bsz, L, SGU_WIDTH)


def peer_ffn(x, w_query, keys, peer_u, peer_v):
    bsz, L, D = x.shape
    q = (x @ w_query).reshape(bsz, L, PEER_HEADS, 2, PEER_HALF)
    s = jnp.einsum('blhcd,chkd->blhck', q, keys)
    sv, si = lax.top_k(s, PEER_TOPK)
    cand = (sv[..., 0, :, None] + sv[..., 1, None, :]).reshape(bsz, L, PEER_HEADS, PEER_TOPK * PEER_TOPK)
    cv, ci = lax.top_k(cand, PEER_TOPK)
    e1 = jnp.take_along_axis(si[..., 0, :], ci // PEER_TOPK, axis=-1)
    e2 = jnp.take_along_axis(si[..., 1, :], ci % PEER_TOPK, axis=-1)
    experts = e1 * N_KEYS + e2
    gates = jax.nn.softmax(cv.astype(jnp.float32), axis=-1)
    n_tok = bsz * L
    nchunk = n_tok // PEER_TOKEN_CHUNK
    xs = x.reshape(nchunk, PEER_TOKEN_CHUNK, D)
    es = experts.reshape(nchunk, PEER_TOKEN_CHUNK, PEER_HEADS * PEER_TOPK)
    gs = gates.reshape(nchunk, PEER_TOKEN_CHUNK, PEER_HEADS * PEER_TOPK)

    def chunk(args):
        xc, ec, gc = args
        u_sel = peer_u[ec]
        h = jnp.einsum('tkd,td->tk', u_sel, xc).astype(jnp.float32)
        a = (jax.nn.gelu(h, approximate=False) * gc).astype(x.dtype)
        v_sel = peer_v[ec]
        return jnp.einsum('tk,tkd->td', a, v_sel)

    out = lax.map(chunk, (xs, es, gs))
    return out.reshape(bsz, L, D).astype(x.dtype)


def setup_inputs(seed: int = 0) -> dict:
    key = jax.random.key(seed)
    ks = jax.random.split(key, 32)
    f32 = jnp.float32
    nrm = lambda k, shape, scale: jax.random.normal(k, shape, f32) * scale
    n_idx = jnp.arange(SSM_STATE, dtype=f32)
    return {
        'x': nrm(ks[0], (BATCH, SEQ, D_MODEL), 1.0),
        'norm1_g': 1.0 + nrm(ks[1], (DEPTH, D_MODEL), 0.02),
        'w_in': nrm(ks[2], (DEPTH, D_MODEL, IN_COLS), D_MODEL ** -0.5),
        'ssm_a_re': -0.5 + nrm(ks[3], (DEPTH, SSM_GROUPS, SSM_STATE), 0.01),
        'ssm_a_im': math.pi * n_idx + nrm(ks[4], (DEPTH, SSM_GROUPS, SSM_STATE), 0.01),
        'ssm_b_re': nrm(ks[5], (DEPTH, SSM_GROUPS, SSM_STATE, SSM_GROUP), (2 * SSM_GROUP) ** -0.5),
        'ssm_b_im': nrm(ks[6], (DEPTH, SSM_GROUPS, SSM_STATE, SSM_GROUP), (2 * SSM_GROUP) ** -0.5),
        'ssm_c_re': nrm(ks[7], (DEPTH, SSM_GROUPS, SSM_GROUP, SSM_STATE), SSM_STATE ** -0.5),
        'ssm_c_im': nrm(ks[8], (DEPTH, SSM_GROUPS, SSM_GROUP, SSM_STATE), SSM_STATE ** -0.5),
        'ssm_d': nrm(ks[9], (DEPTH, SSM_WIDTH), 1.0),
        'ssm_log_dt': jax.random.uniform(ks[10], (DEPTH, SSM_GROUPS), f32, math.log(DT_MIN), math.log(DT_MAX)),
        'w_glu': nrm(ks[11], (DEPTH, SSM_WIDTH, SSM_WIDTH), SSM_WIDTH ** -0.5),
        'b_glu': nrm(ks[12], (DEPTH, SSM_WIDTH), 0.01),
        'q_norm_g': 1.0 + nrm(ks[13], (DEPTH, HEAD_DIM), 0.02),
        'k_norm_g': 1.0 + nrm(ks[14], (DEPTH, HEAD_DIM), 0.02),
        'attn_sinks': nrm(ks[15], (DEPTH, N_Q_HEADS), 0.5),
        'sgu_ln_g': 1.0 + nrm(ks[16], (DEPTH, SGU_WIDTH), 0.02),
        'sgu_ln_b': nrm(ks[17], (DEPTH, SGU_WIDTH), 0.01),
        'sgu_w': nrm(ks[18], (DEPTH, SGU_HEADS, SGU_CHUNK, SGU_CHUNK), SGU_CHUNK ** -0.5),
        'sgu_b': 1.0 + nrm(ks[19], (DEPTH, SGU_HEADS, SGU_CHUNK), 0.02),
        'w_branch': nrm(ks[20], (DEPTH, N_BRANCH, BRANCH_WIDTH, D_MODEL), BRANCH_WIDTH ** -0.5),
        'w_out': nrm(ks[21], (DEPTH, D_MODEL, D_MODEL), 0.5 * D_MODEL ** -0.5),
        'norm2_g': 1.0 + nrm(ks[22], (DEPTH, D_MODEL), 0.02),
        'w_query': nrm(ks[23], (DEPTH, D_MODEL, PEER_HEADS * PEER_QDIM), D_MODEL ** -0.5),
        'peer_keys': nrm(ks[24], (DEPTH, 2, PEER_HEADS, N_KEYS, PEER_HALF), PEER_HALF ** -0.5),
        'peer_u': nrm(ks[25], (DEPTH, N_EXPERTS, D_MODEL), D_MODEL ** -0.5),
        'peer_v': nrm(ks[26], (DEPTH, N_EXPERTS, D_MODEL), 0.1),
    }


def reference(x, norm1_g, w_in, ssm_a_re, ssm_a_im, ssm_b_re, ssm_b_im, ssm_c_re, ssm_c_im,
              ssm_d, ssm_log_dt, w_glu, b_glu, q_norm_g, k_norm_g, attn_sinks,
              sgu_ln_g, sgu_ln_b, sgu_w, sgu_b, w_branch, w_out, norm2_g,
              w_query, peer_keys, peer_u, peer_v):
    bsz, L = x.shape[0], x.shape[1]
    for l in range(DEPTH):
        h = rms_norm(x, norm1_g[l])
        proj = h @ w_in[l]
        p_ssm, p_q, p_k, p_v, p_sgu, p_gate = jnp.split(proj, SPLIT_POINTS, axis=-1)
        y_a = s5_branch(p_ssm, ssm_a_re[l], ssm_a_im[l], ssm_b_re[l], ssm_b_im[l],
                        ssm_c_re[l], ssm_c_im[l], ssm_d[l], ssm_log_dt[l], w_glu[l], b_glu[l])
        y_b = sliding_window_attention(p_q, p_k, p_v, q_norm_g[l], k_norm_g[l], attn_sinks[l])
        y_c = spatial_gating(p_sgu, sgu_ln_g[l], sgu_ln_b[l], sgu_w[l], sgu_b[l])
        ys = jnp.stack([y_a, y_b, y_c], axis=2)
        branch = jnp.einsum('bsnc,ncd->bsnd', ys, w_branch[l])
        gates = jax.nn.sigmoid(p_gate.astype(jnp.float32)).reshape(bsz, L, N_BRANCH, D_MODEL)
        merged = jnp.sum(gates * branch.astype(jnp.float32), axis=2).astype(x.dtype)
        x = x + merged @ w_out[l]
        x = x + peer_ffn(rms_norm(x, norm2_g[l]), w_query[l], peer_keys[l], peer_u[l], peer_v[l])
    return x
```

```cpp
#include <hip/hip_runtime.h>
#include <hip/hip_cooperative_groups.h>
#include <cstdio>
#include <cstdint>
namespace cg = cooperative_groups;
#define N_LAUNCH_MODE 1
namespace pg8 {
#define PG8_LAS __attribute__((address_space(3)))
typedef unsigned short bf16_t;
typedef short bf16x8 __attribute__((ext_vector_type(8)));
typedef float f32x4 __attribute__((ext_vector_type(4)));
typedef unsigned u32x4 __attribute__((ext_vector_type(4)));
constexpr int BM = 256, BK = 64, HALF = 128, HTB = HALF * BK * 2  , STAGE_BYTES = 8 * HTB, NXCD = 8, WGM = 8;

__host__ __device__ __forceinline__ int lds_byte(int r, int c) { const int st = (r >> 4) * 2 + (c >> 5), rr = r & 15, cc = c & 31, ob = rr * 64 + cc * 2; return st * 1024 + (ob ^ (((ob >> 9) & 1) << 5)); }
__host__ __device__ __forceinline__ void stage_rc(int b, int& R, int& C) { const int st = b / 1024, sb = b % 1024, swz = sb ^ (((sb >> 9) & 1) << 5); R = (st >> 1) * 16 + swz / 64; C = (st & 1) * 32 + (swz % 64) / 2; }
__host__ __device__ __forceinline__ int perm32(int rho) { const int n = rho >> 4, i = rho & 15; return 8 * (i >> 2) + 4 * n + (i & 3); }

struct Unit { int pm, pn; };
struct Gemm { const bf16_t* A; const bf16_t* Bt; int M, N, K; };

struct StaticOrder {
    int nM, nN, nwg, G, c;
    __host__ __device__ void init(int M, int N, int G_, int c_) { nM = M / BM; nN = N / BM; nwg = nM * nN; G = G_; c = c_; }
    __host__ __device__ bool next(int i, Unit& u) const {
        const long L = (long)i * G + c; if (L >= nwg) return false;
        int wgid = (int)L; { const int q = nwg / NXCD, r = nwg % NXCD, xcd = wgid % NXCD, off = wgid / NXCD; wgid = (xcd < r ? xcd * (q + 1) : r * (q + 1) + (xcd - r) * q) + off; }
        const int nig = WGM * nN, gid = wgid / nig, fm = gid * WGM, gsz = (nM - fm) < WGM ? (nM - fm) : WGM;
        u.pm = fm + ((wgid % nig) % gsz); u.pn = (wgid % nig) / gsz; return true;
    }
    __device__ __forceinline__ void a_ready(const Unit&) const {}
    __device__ __forceinline__ void done(const Unit&) const {}
};

__device__ __forceinline__ unsigned cvt_pk_bf16(float lo, float hi) { unsigned r; asm volatile("v_cvt_pk_bf16_f32 %0, %1, %2" : "=v"(r) : "v"(lo), "v"(hi)); return r; }
typedef float f32x2 __attribute__((ext_vector_type(2)));
__device__ __forceinline__ f32x2 gelu_pk(f32x2 v) {
    const f32x2 av = __builtin_elementwise_abs(v), d = av * 0.2316418882f + 1.0f;
    f32x2 t; t.x = __builtin_amdgcn_rcpf(d.x); t.y = __builtin_amdgcn_rcpf(d.y);
    f32x2 q = t * 0.5307027145f + (-0.7265760135f); q = q * t + 0.7107068705f; q = q * t + (-0.142248368f); q = q * t + 0.127414796f; q = q * t;
    const f32x2 s = (v * v) * (-0.72134752044f);
    f32x2 e; e.x = __builtin_amdgcn_exp2f(s.x); e.y = __builtin_amdgcn_exp2f(s.y);
    const f32x2 m = v * (q * e), r = v - m;
    f32x2 o; o.x = v.x < 0.f ? m.x : r.x; o.y = v.y < 0.f ? m.y : r.y; return o;
}
template <class Epi, class Sched, bool ALIGN_EPI = false, bool SP2 = false>
__device__ __forceinline__ void gemm_phase(PG8_LAS unsigned char* lds, const Gemm g, const Sched& S, const Epi& E) {
    int tid_opaque = threadIdx.x; asm volatile("" : "+v"(tid_opaque));
    const int tid = tid_opaque, wid = __builtin_amdgcn_readfirstlane(tid >> 6), lane = tid & 63, wr = wid >> 2, wc = wid & 3, fr = lane & 15, fq = lane >> 4;
    const int K = g.K, nt = K / BK;
    unsigned voffA[2], voffB[2];
#pragma unroll
    for (int i = 0; i < 2; ++i) { int R, C; stage_rc(tid * 16 + i * 8192, R, C); const int Rb = Epi::PERM ? ((R & ~31) + perm32(R & 31)) : R;
        voffA[i] = (unsigned)(R * K + C) * 2u; voffB[i] = (unsigned)(Rb * K + C) * 2u; }
    const size_t kstep = (size_t)(BK * 2);
    const size_t hstep = (size_t)HALF * K * 2;
    const size_t tstep = 2 * hstep;
    const unsigned ldsw = (unsigned)wid * 1024u;
    const int aoff = lds_byte(wr * 64 + fr, fq * 8), boff = lds_byte(wc * 32 + fr, fq * 8);
#define PG8_SA(b, h) (((b) * 2 + (h)) * HTB)
#define PG8_SB(b, h) ((4 + (b) * 2 + (h)) * HTB)
#define PG8_STAGE(bufoff, gbase, voff) do { _Pragma("unroll") for (int _i = 0; _i < 2; ++_i) \
        __builtin_amdgcn_global_load_lds((const unsigned*)((const char*)(gbase) + (voff)[_i]), (PG8_LAS unsigned*)(lds + (bufoff) + ldsw + _i * 8192), 16, 0, 0); } while (0)
#define PG8_LDA(dst, b, h) do { _Pragma("unroll") for (int m = 0; m < 4; ++m) _Pragma("unroll") for (int k = 0; k < 2; ++k) dst[m][k] = *(const PG8_LAS bf16x8*)(lds + PG8_SA(b, h) + aoff + m * 2048 + k * 1024); } while (0)
#define PG8_LDB(dst, b, h) do { _Pragma("unroll") for (int n = 0; n < 2; ++n) _Pragma("unroll") for (int k = 0; k < 2; ++k) dst[n][k] = *(const PG8_LAS bf16x8*)(lds + PG8_SB(b, h) + boff + n * 2048 + k * 1024); } while (0)
#define PG8_MMA(ai, bj, At, Bt) do { __builtin_amdgcn_s_setprio(1); _Pragma("unroll") for (int m = 0; m < 4; ++m) _Pragma("unroll") for (int n = 0; n < 2; ++n) _Pragma("unroll") for (int k = 0; k < 2; ++k) \
        acc[ai][bj][m][n] = __builtin_amdgcn_mfma_f32_16x16x32_bf16(Bt[n][k], At[m][k], acc[ai][bj][m][n], 0, 0, 0); __builtin_amdgcn_s_setprio(0); } while (0)
#define PG8_WAIT_V(n) asm volatile("s_waitcnt vmcnt(" #n ")" ::: "memory")
#define PG8_WAIT_L(n) asm volatile("s_waitcnt lgkmcnt(" #n ")" ::: "memory")
#define PG8_BAR __builtin_amdgcn_s_barrier()
#define PG8_SCHED __builtin_amdgcn_sched_barrier(0)
    Unit cur, nxt; int ui = 0;
    if (!S.next(0, cur)) return;
    f32x4 acc[2][2][4][2];
#pragma unroll
    for (int a = 0; a < 2; ++a)
#pragma unroll
        for (int b = 0; b < 2; ++b)
#pragma unroll
            for (int m = 0; m < 4; ++m)
#pragma unroll
                for (int n = 0; n < 2; ++n) acc[a][b][m][n] = (f32x4){0.f, 0.f, 0.f, 0.f};
    bf16x8 At[4][2], B0[2][2], B1[2][2];
    const char* cA = (const char*)g.A + (size_t)cur.pm * tstep; const char* cB = (const char*)g.Bt + (size_t)cur.pn * tstep;
    S.a_ready(cur);
    if constexpr (SP2) {
        PG8_STAGE(PG8_SB(0, 0), cB, voffB); PG8_STAGE(PG8_SB(0, 1), cB + hstep, voffB); PG8_STAGE(PG8_SA(0, 0), cA, voffA); PG8_STAGE(PG8_SA(0, 1), cA + hstep, voffA);
        if (wr == 1) PG8_BAR;
        PG8_WAIT_V(2); PG8_BAR;
        PG8_STAGE(PG8_SB(1, 0), cB + kstep, voffB); PG8_STAGE(PG8_SA(1, 0), cA + kstep, voffA); PG8_STAGE(PG8_SB(1, 1), cB + hstep + kstep, voffB);
        PG8_WAIT_V(6); PG8_BAR;
    } else {
        PG8_STAGE(PG8_SB(0, 0), cB, voffB); PG8_STAGE(PG8_SA(0, 0), cA, voffA); PG8_STAGE(PG8_SB(0, 1), cB + hstep, voffB); PG8_STAGE(PG8_SA(0, 1), cA + hstep, voffA);
        if (wr == 1) PG8_BAR;
        PG8_WAIT_V(4); PG8_BAR;
        PG8_STAGE(PG8_SB(1, 0), cB + kstep, voffB); PG8_STAGE(PG8_SA(1, 0), cA + kstep, voffA); PG8_STAGE(PG8_SB(1, 1), cB + hstep + kstep, voffB);
        PG8_WAIT_V(6); PG8_BAR;
    }
    for (;;) {
        const bool has_next = S.next(ui + 1, nxt);
        const char* nA = has_next ? (const char*)g.A + (size_t)nxt.pm * tstep : cA; const char* nB = has_next ? (const char*)g.Bt + (size_t)nxt.pn * tstep : cB;
        for (int t = 0; t < nt; t += 2) {
            const bool last = (t == nt - 2);
            const char* a1 = cA + (size_t)(t + 1) * kstep;
            const char* a2 = last ? nA : cA + (size_t)(t + 2) * kstep; const char* b2 = last ? nB : cB + (size_t)(t + 2) * kstep;
            const char* a3 = a2 + kstep; const char* b3 = b2 + kstep;
            if (last && has_next) S.a_ready(nxt);
            if constexpr (SP2) {
            PG8_LDB(B0, 0, 0); PG8_LDB(B1, 0, 1); PG8_SCHED; PG8_LDA(At, 0, 0); PG8_STAGE(PG8_SA(1, 1), a1 + hstep, voffA);
            PG8_WAIT_V(8); PG8_WAIT_L(0); PG8_BAR; PG8_MMA(0, 0, At, B0); PG8_MMA(0, 1, At, B1); PG8_BAR; PG8_SCHED;
            PG8_LDA(At, 0, 1); PG8_STAGE(PG8_SB(0, 0), b2, voffB); PG8_STAGE(PG8_SB(0, 1), b2 + hstep, voffB); PG8_STAGE(PG8_SA(0, 0), a2, voffA);
            PG8_WAIT_V(8); PG8_WAIT_L(0); PG8_BAR; PG8_MMA(1, 0, At, B0); PG8_MMA(1, 1, At, B1); PG8_BAR; PG8_SCHED;
            PG8_LDB(B0, 1, 0); PG8_LDB(B1, 1, 1); PG8_SCHED; PG8_LDA(At, 1, 0); PG8_STAGE(PG8_SA(0, 1), a2 + hstep, voffA);
            PG8_WAIT_V(8); PG8_WAIT_L(0); PG8_BAR; PG8_MMA(0, 0, At, B0); PG8_MMA(0, 1, At, B1); PG8_BAR; PG8_SCHED;
            PG8_LDA(At, 1, 1); PG8_STAGE(PG8_SB(1, 0), b3, voffB); PG8_STAGE(PG8_SB(1, 1), b3 + hstep, voffB); PG8_STAGE(PG8_SA(1, 0), a3, voffA);
            PG8_WAIT_V(8); PG8_WAIT_L(0); PG8_BAR; PG8_MMA(1, 0, At, B0); PG8_MMA(1, 1, At, B1); PG8_BAR; PG8_SCHED;
            } else {
            PG8_LDB(B0, 0, 0); PG8_SCHED; PG8_LDA(At, 0, 0); PG8_STAGE(PG8_SA(1, 1), a1 + hstep, voffA);
            PG8_WAIT_L(8); PG8_BAR; PG8_WAIT_L(0); PG8_MMA(0, 0, At, B0); PG8_BAR; PG8_SCHED;
            PG8_LDB(B1, 0, 1); PG8_STAGE(PG8_SB(0, 0), b2, voffB);
            PG8_BAR; PG8_WAIT_L(0); PG8_MMA(0, 1, At, B1); PG8_BAR;
            PG8_LDA(At, 0, 1); PG8_STAGE(PG8_SA(0, 0), a2, voffA);
            PG8_BAR; PG8_WAIT_L(0); PG8_MMA(1, 0, At, B0); PG8_BAR; PG8_SCHED;
            PG8_STAGE(PG8_SB(0, 1), b2 + hstep, voffB);
            PG8_WAIT_V(6); PG8_BAR; PG8_MMA(1, 1, At, B1); PG8_BAR;
            PG8_LDB(B0, 1, 0); PG8_SCHED; PG8_LDA(At, 1, 0); PG8_STAGE(PG8_SA(0, 1), a2 + hstep, voffA);
            PG8_WAIT_L(8); PG8_BAR; PG8_WAIT_L(0); PG8_MMA(0, 0, At, B0); PG8_BAR; PG8_SCHED;
            PG8_LDB(B1, 1, 1); PG8_STAGE(PG8_SB(1, 0), b3, voffB);
            PG8_BAR; PG8_WAIT_L(0); PG8_MMA(0, 1, At, B1); PG8_BAR;
            PG8_LDA(At, 1, 1); PG8_STAGE(PG8_SA(1, 0), a3, voffA);
            PG8_BAR; PG8_WAIT_L(0); PG8_MMA(1, 0, At, B0); PG8_BAR; PG8_SCHED;
            PG8_STAGE(PG8_SB(1, 1), b3 + hstep, voffB);
            PG8_WAIT_V(6); PG8_BAR; PG8_MMA(1, 1, At, B1); PG8_BAR;
            }
        }
        if constexpr (ALIGN_EPI) { if (wr == 0) PG8_BAR; }
        if constexpr (!Epi::AFTER_DRAIN) { E(acc, cur, wr, wc, fr, fq); S.done(cur); }
        if (!has_next) break;
        if (!(Epi::CHAIN && E.keep(cur))) {
#pragma unroll
        for (int a = 0; a < 2; ++a)
#pragma unroll
            for (int b = 0; b < 2; ++b)
#pragma unroll
                for (int m = 0; m < 4; ++m)
#pragma unroll
                    for (int n = 0; n < 2; ++n) acc[a][b][m][n] = (f32x4){0.f, 0.f, 0.f, 0.f};
        }
        cur = nxt; cA = nA; cB = nB; ++ui;
        if constexpr (ALIGN_EPI) { if (wr == 1) PG8_BAR; }
    }
    PG8_WAIT_V(0);
    if constexpr (!ALIGN_EPI) { if (wr == 0) PG8_BAR; }
    PG8_BAR;
    if constexpr (Epi::AFTER_DRAIN) { E.fused(acc, cur, wr, wc, fr, fq, lds, wid, lane); S.done(cur); }
#undef PG8_SA
#undef PG8_SB
#undef PG8_STAGE
#undef PG8_LDA
#undef PG8_LDB
#undef PG8_MMA
#undef PG8_WAIT_V
#undef PG8_WAIT_L
#undef PG8_BAR
#undef PG8_SCHED
}
}

#ifndef REP_MASK
#define REP_MASK 0
#endif
#ifndef PROBE_T
#define PROBE_T 0
#endif
#ifndef PROBE_P
#define PROBE_P 0
#endif
#ifndef PROBE_S
#define PROBE_S 0
#endif
#ifndef PROBE_D
#define PROBE_D 0
#endif
#ifndef PROBE_Y
#define PROBE_Y 0
#endif
#ifndef REP_SYNC
#define REP_SYNC 0
#endif
#ifndef REP_MIX
#define REP_MIX 0
#endif
#ifndef MIX_ON
#define MIX_ON 7
#endif
#ifndef PH_ON
#define PH_ON 1023
#endif
#ifndef N_LAUNCH_MODE
#define N_LAUNCH_MODE 1
#endif
#define LAS __attribute__((address_space(3)))
typedef unsigned short bf16;
typedef unsigned v4u __attribute__((ext_vector_type(4)));
typedef unsigned v2u __attribute__((ext_vector_type(2)));
typedef int v4i __attribute__((ext_vector_type(4)));
typedef float f32x4 __attribute__((ext_vector_type(4)));
typedef float f32x2 __attribute__((ext_vector_type(2)));

constexpr int NTHR = 512;
constexpr int M = 8192, D = 2048, DEPTH = 2, INC = 10752;
constexpr int C_Q = 1024, C_K = 2048, C_V = 2304, C_SGU = 2560, C_GATE = 4608;
constexpr float EPS = 1e-6f;
constexpr int LDS_BYTES = 147456;
constexpr int NPHASE = 1 + 8 * DEPTH;
constexpr size_t MiB = 1u << 20;
constexpr size_t WS_ABAR = 1 * MiB, WS_BBAR = 2 * MiB, WS_SCL = 3 * MiB, WS_SEND = 4 * MiB, WS_WIN = 8 * MiB, WS_WGLU = 92 * MiB, WS_WBR = 96 * MiB, WS_WOUT = 120 * MiB,
                 WS_WQK = 136 * MiB, WS_PU = 152 * MiB, WS_PV = 280 * MiB, WS_H = 408 * MiB, WS_XN = 440 * MiB, WS_PROJ = 472 * MiB, WS_YG = 640 * MiB,
                 WS_YS = 656 * MiB, WS_MTMP = 704 * MiB, WS_MERGED = 768 * MiB, WS_SCORES = 800 * MiB, WS_END = 864 * MiB;

#define LDS_WAIT() asm volatile("s_waitcnt lgkmcnt(0)" ::: "memory")
__device__ __forceinline__ unsigned pk2(float lo, float hi) { return pg8::cvt_pk_bf16(lo, hi); }
__device__ __forceinline__ float bflo(unsigned w) { return __uint_as_float(w << 16); }
__device__ __forceinline__ float bfhi(unsigned w) { return __uint_as_float(w & 0xffff0000u); }
__device__ __forceinline__ void unpack8(const v4u w, float* f) { f[0] = bflo(w.x); f[1] = bfhi(w.x); f[2] = bflo(w.y); f[3] = bfhi(w.y); f[4] = bflo(w.z); f[5] = bfhi(w.z); f[6] = bflo(w.w); f[7] = bfhi(w.w); }
__device__ __forceinline__ v4u pack8(const float* f) { v4u o; o.x = pk2(f[0], f[1]); o.y = pk2(f[2], f[3]); o.z = pk2(f[4], f[5]); o.w = pk2(f[6], f[7]); return o; }
__device__ __forceinline__ float wave_sum(float v) {
#pragma unroll
    for (int o = 1; o < 64; o <<= 1) v += __shfl_xor(v, o);
    return v;
}
__device__ __forceinline__ float gelu_s(float v) {
    const float av = fabsf(v), d = av * 0.2316418882f + 1.0f; const float t = __builtin_amdgcn_rcpf(d);
    float q = t * 0.5307027145f + (-0.7265760135f); q = q * t + 0.7107068705f; q = q * t + (-0.142248368f); q = q * t + 0.127414796f; q = q * t;
    const float e = __builtin_amdgcn_exp2f(v * v * (-0.72134752044f));
    const float m = v * (q * e); return v < 0.f ? m : v - m;
}
__device__ __forceinline__ float sigmoid_s(float v) { return __builtin_amdgcn_rcpf(1.0f + __builtin_amdgcn_exp2f(-1.4426950408889634f * v)); }

__device__ __forceinline__ float ld_acc(const float* p) { return __hip_atomic_load(p, __ATOMIC_RELAXED, __HIP_MEMORY_SCOPE_AGENT); }
struct EpiProj {
    static constexpr bool PERM = true, AFTER_DRAIN = false, CHAIN = false; __device__ __forceinline__ bool keep(const pg8::Unit&) const { return false; } bf16* O;
    __device__ __forceinline__ void operator()(const pg8::f32x4 (&acc)[2][2][4][2], const pg8::Unit& u, int wr, int wc, int fr, int fq) const {
        const int row0 = u.pm * 256 + wr * 64 + fr, col0 = u.pn * 256 + wc * 32 + 8 * fq;
        const int act = u.pn < 10 ? 0 : (u.pn < 18 ? 1 : 2);
#pragma unroll
        for (int ai = 0; ai < 2; ++ai)
#pragma unroll
            for (int m = 0; m < 4; ++m) { bf16* rowp = O + (size_t)(row0 + ai * 128 + m * 16) * INC + col0;
#pragma unroll
                for (int bj = 0; bj < 2; ++bj) { float v[8];
#pragma unroll
                    for (int e = 0; e < 4; ++e) { v[e] = acc[ai][bj][m][0][e]; v[4 + e] = acc[ai][bj][m][1][e]; }
                    if (act == 1) {
#pragma unroll
                        for (int e = 0; e < 8; ++e) v[e] = gelu_s(v[e]);
                    } else if (act == 2) {
#pragma unroll
                        for (int e = 0; e < 8; ++e) v[e] = sigmoid_s(v[e]);
                    }
                    *(v4u*)(rowp + bj * 128) = pack8(v); } }
    }
};
struct EpiGlu {
    static constexpr bool PERM = true, AFTER_DRAIN = false, CHAIN = false; __device__ __forceinline__ bool keep(const pg8::Unit&) const { return false; } const bf16* YG; const float* bias; bf16* O;
    __device__ __forceinline__ void operator()(const pg8::f32x4 (&acc)[2][2][4][2], const pg8::Unit& u, int wr, int wc, int fr, int fq) const {
        const int row0 = u.pm * 256 + wr * 64 + fr, col0 = u.pn * 256 + wc * 32 + 8 * fq;
#pragma unroll
        for (int bj = 0; bj < 2; ++bj) { const f32x4 b0 = *(const f32x4*)(bias + col0 + bj * 128), b1 = *(const f32x4*)(bias + col0 + bj * 128 + 4);
#pragma unroll
            for (int ai = 0; ai < 2; ++ai)
#pragma unroll
                for (int m = 0; m < 4; ++m) { const size_t off = (size_t)(row0 + ai * 128 + m * 16) * 1024 + col0 + bj * 128;
                    float y[8]; unpack8(*(const v4u*)(YG + off), y); float v[8];
#pragma unroll
                    for (int e = 0; e < 4; ++e) { v[e] = y[e] * sigmoid_s(acc[ai][bj][m][0][e] + b0[e]); v[4 + e] = y[4 + e] * sigmoid_s(acc[ai][bj][m][1][e] + b1[e]); }
                    *(v4u*)(O + off) = pack8(v); } }
    }
};
struct EpiBranch {
    static constexpr bool PERM = true, AFTER_DRAIN = false, CHAIN = true; const bf16* proj; bf16* merged;
    __device__ __forceinline__ bool keep(const pg8::Unit& u) const { return (u.pm >> 5) < 2; }
    __device__ __forceinline__ void operator()(pg8::f32x4 (&acc)[2][2][4][2], const pg8::Unit& u, int wr, int wc, int fr, int fq) const {
        const int n = u.pm >> 5, pm = u.pm & 31, pn = u.pn & 7;
        const int row0 = pm * 256 + wr * 64 + fr, col0 = pn * 256 + wc * 32 + 8 * fq;
#pragma unroll
        for (int ai = 0; ai < 2; ++ai)
#pragma unroll
            for (int m = 0; m < 4; ++m) { const int row = row0 + ai * 128 + m * 16;
#pragma unroll
                for (int bj = 0; bj < 2; ++bj) { const int col = col0 + bj * 128; const bf16* gp = proj + (size_t)row * INC + C_GATE + n * 2048 + col;
                    float g[8]; unpack8(*(const v4u*)gp, g);
                    if (n < 2) { float gn[8]; unpack8(*(const v4u*)(gp + 2048), gn);
#pragma unroll
                        for (int e = 0; e < 8; ++e) g[e] = fmaxf(g[e], 1e-30f) * __builtin_amdgcn_rcpf(fmaxf(gn[e], 1e-30f));
#pragma unroll
                        for (int e = 0; e < 4; ++e) { acc[ai][bj][m][0][e] *= g[e]; acc[ai][bj][m][1][e] *= g[4 + e]; }
                    } else { float v[8];
#pragma unroll
                        for (int e = 0; e < 4; ++e) { v[e] = fmaxf(g[e], 1e-30f) * acc[ai][bj][m][0][e]; v[4 + e] = fmaxf(g[4 + e], 1e-30f) * acc[ai][bj][m][1][e]; }
                        *(v4u*)(merged + (size_t)row * 2048 + col) = pack8(v); } } }
    }
};
struct RangeOrder {
    pg8::StaticOrder base; int lo, hi, G2, c2;
    __device__ __forceinline__ bool next(int i, pg8::Unit& u) const { const int L = lo + i * G2 + c2; if (L >= hi) return false; pg8::StaticOrder t = base; t.c = L % base.G; return t.next(L / base.G, u); }
    __device__ __forceinline__ void a_ready(const pg8::Unit&) const {}
    __device__ __forceinline__ void done(const pg8::Unit&) const {}
};
struct BranchOrder {
    int G, c;
    __device__ __forceinline__ bool next(int i, pg8::Unit& u) const { const int L = (i / 3) * G + c; if (L >= 256) return false; const int n = i % 3; u.pm = n * 32 + (L >> 3); u.pn = n * 8 + (L & 7); return true; }
    __device__ __forceinline__ void a_ready(const pg8::Unit&) const {}
    __device__ __forceinline__ void done(const pg8::Unit&) const {}
};
struct EpiResid {
    static constexpr bool PERM = false, AFTER_DRAIN = false, CHAIN = false; __device__ __forceinline__ bool keep(const pg8::Unit&) const { return false; } const float* base; float* out;
    __device__ __forceinline__ void operator()(const pg8::f32x4 (&acc)[2][2][4][2], const pg8::Unit& u, int wr, int wc, int fr, int fq) const {
        const int row0 = u.pm * 256 + wr * 64 + fr, col0 = u.pn * 256 + wc * 32 + 4 * fq;
#pragma unroll
        for (int ai = 0; ai < 2; ++ai)
#pragma unroll
            for (int m = 0; m < 4; ++m) { const size_t off = (size_t)(row0 + ai * 128 + m * 16) * 2048 + col0;
#pragma unroll
                for (int bj = 0; bj < 2; ++bj)
#pragma unroll
                    for (int n = 0; n < 2; ++n) { const f32x4 b = *(const f32x4*)(base + off + bj * 128 + n * 16); f32x4 o;
#pragma unroll
                        for (int e = 0; e < 4; ++e) o[e] = b[e] + acc[ai][bj][m][n][e];
                        *(f32x4*)(out + off + bj * 128 + n * 16) = o; } }
    }
};
struct EpiResidNorm {
    static constexpr bool PERM = false, AFTER_DRAIN = false, CHAIN = false; __device__ __forceinline__ bool keep(const pg8::Unit&) const { return false; } const float* base; float* out; const float* g2; bf16* xnb; float* rowss;
    __device__ __forceinline__ void operator()(const pg8::f32x4 (&acc)[2][2][4][2], const pg8::Unit& u, int wr, int wc, int fr, int fq) const {
        const int row0 = u.pm * 256 + wr * 64 + fr, col0 = u.pn * 256 + wc * 32 + 4 * fq;
#pragma unroll
        for (int ai = 0; ai < 2; ++ai)
#pragma unroll
            for (int m = 0; m < 4; ++m) { const int row = row0 + ai * 128 + m * 16; const size_t off = (size_t)row * 2048 + col0; float ss = 0.f;
#pragma unroll
                for (int bj = 0; bj < 2; ++bj)
#pragma unroll
                    for (int n = 0; n < 2; ++n) { const f32x4 b = *(const f32x4*)(base + off + bj * 128 + n * 16); const f32x4 g = *(const f32x4*)(g2 + col0 + bj * 128 + n * 16); f32x4 o;
#pragma unroll
                        for (int e = 0; e < 4; ++e) { o[e] = b[e] + acc[ai][bj][m][n][e]; ss += o[e] * o[e]; }
                        *(f32x4*)(out + off + bj * 128 + n * 16) = o;
                        v2u w; w.x = pk2(o[0] * g[0], o[1] * g[1]); w.y = pk2(o[2] * g[2], o[3] * g[3]); *(v2u*)(xnb + off + bj * 128 + n * 16) = w; }
                ss += __shfl_xor(ss, 16); ss += __shfl_xor(ss, 32);
                if (fq == 0) rowss[(size_t)row * 32 + u.pn * 4 + wc] = ss; }
    }
};
struct EpiScoreF32 {
    static constexpr bool PERM = false, AFTER_DRAIN = false, CHAIN = false; __device__ __forceinline__ bool keep(const pg8::Unit&) const { return false; } float* out; const float* rowss;
    __device__ __forceinline__ void operator()(const pg8::f32x4 (&acc)[2][2][4][2], const pg8::Unit& u, int wr, int wc, int fr, int fq) const {
        const int row0 = u.pm * 256 + wr * 64 + fr, col0 = u.pn * 256 + wc * 32 + 4 * fq;
#pragma unroll
        for (int ai = 0; ai < 2; ++ai)
#pragma unroll
            for (int m = 0; m < 4; ++m) { const int row = row0 + ai * 128 + m * 16; const size_t off = (size_t)row * 2048 + col0; const f32x4* pp = (const f32x4*)(rowss + (size_t)row * 32) + fq * 2; const f32x4 p0 = pp[0], p1 = pp[1]; float sq = ((p0.x + p0.y) + (p0.z + p0.w)) + ((p1.x + p1.y) + (p1.z + p1.w)); sq += __shfl_xor(sq, 16); sq += __shfl_xor(sq, 32);
                const float rstd = rsqrtf(sq * (1.f / 2048.f) + EPS);
#pragma unroll
                for (int bj = 0; bj < 2; ++bj)
#pragma unroll
                    for (int n = 0; n < 2; ++n) { f32x4 o;
#pragma unroll
                        for (int e = 0; e < 4; ++e) o[e] = acc[ai][bj][m][n][e] * rstd;
                        *(f32x4*)(out + off + bj * 128 + n * 16) = o; } }
    }
};
struct EpiF32 {
    static constexpr bool PERM = false, AFTER_DRAIN = false, CHAIN = false; __device__ __forceinline__ bool keep(const pg8::Unit&) const { return false; } float* out;
    __device__ __forceinline__ void operator()(const pg8::f32x4 (&acc)[2][2][4][2], const pg8::Unit& u, int wr, int wc, int fr, int fq) const {
        const int row0 = u.pm * 256 + wr * 64 + fr, col0 = u.pn * 256 + wc * 32 + 4 * fq;
#pragma unroll
        for (int ai = 0; ai < 2; ++ai)
#pragma unroll
            for (int m = 0; m < 4; ++m) { const size_t off = (size_t)(row0 + ai * 128 + m * 16) * 2048 + col0;
#pragma unroll
                for (int bj = 0; bj < 2; ++bj)
#pragma unroll
                    for (int n = 0; n < 2; ++n) { f32x4 o;
#pragma unroll
                        for (int e = 0; e < 4; ++e) o[e] = acc[ai][bj][m][n][e];
                        *(f32x4*)(out + off + bj * 128 + n * 16) = o; } }
    }
};

__device__ __forceinline__ void p0_transpose_item(const float* __restrict__ W, int K, int N, bf16* WT, LAS float* scr, int item, int lane) {
    const int nblk = N / 32, kb = item / nblk, nb = item % nblk, k0 = 64 * kb, n0 = 32 * nb;
    float wv[32];
#pragma unroll
    for (int i = 0; i < 32; ++i) wv[i] = W[(size_t)(k0 + 2 * i + (lane >> 5)) * N + n0 + (lane & 31)];
#pragma unroll
    for (int i = 0; i < 32; ++i) scr[(2 * i + (lane >> 5)) * 33 + (lane & 31)] = wv[i];
    LDS_WAIT();
    const int c = lane & 7;
#pragma unroll
    for (int j = 0; j < 4; ++j) { const int n = (lane >> 3) + 8 * j; const LAS float* s = scr + (8 * c) * 33 + n;
        v4u o; o.x = pk2(s[0 * 33], s[1 * 33]); o.y = pk2(s[2 * 33], s[3 * 33]); o.z = pk2(s[4 * 33], s[5 * 33]); o.w = pk2(s[6 * 33], s[7 * 33]);
        *(v4u*)(WT + (size_t)(n0 + n) * K + k0 + 8 * c) = o; }
    LDS_WAIT();
}
__device__ __forceinline__ void rms_row_to_bf16(const float* xrow, const float* g, bf16* orow, int lane) {
    const f32x4* xr = (const f32x4*)xrow + lane; const f32x4* gr = (const f32x4*)g + lane;
    f32x4 v[8]; float s = 0.f;
#pragma unroll
    for (int j = 0; j < 8; ++j) { v[j] = xr[64 * j]; s += (v[j].x * v[j].x + v[j].y * v[j].y) + (v[j].z * v[j].z + v[j].w * v[j].w); }
    const float rstd = rsqrtf(wave_sum(s) * (1.f / 2048.f) + EPS);
    v2u* o8 = (v2u*)orow + lane;
#pragma unroll
    for (int j = 0; j < 8; ++j) { const f32x4 gg = gr[64 * j]; v2u o; o.x = pk2(v[j].x * rstd * gg.x, v[j].y * rstd * gg.y); o.y = pk2(v[j].z * rstd * gg.z, v[j].w * rstd * gg.w); o8[64 * j] = o; }
}

typedef short s16x4 __attribute__((ext_vector_type(4)));
template <bool PASS_C>
__device__ __forceinline__ void ssm_item(int item, int l, const bf16* proj, const float* abar, const bf16* bbt, const float* cre, const float* cim, const float* dvec,
                                         float* send, bf16* yg, LAS unsigned char* lds, int tid, int lane, int wave, int nblk = 16) {
    const int b = item >> 7, g = (item >> 1) & 63, c = (item & 1) * 8 + wave;
    const int tok0 = b * 4096 + c * 256;
    LAS unsigned char* UL = lds + wave * 16640; LAS float* BL = (LAS float*)(lds + wave * 16640 + 8192); LAS float* SL = BL;
    const int c16 = lane & 15, quad = lane >> 4;
    { v4u uw[8];
#pragma unroll
      for (int i = 0; i < 4; ++i) { const v4u* up = (const v4u*)(proj + (size_t)(tok0 + i * 64 + lane) * INC + g * 16); uw[2 * i] = up[0]; uw[2 * i + 1] = up[1]; }
#pragma unroll
      for (int i = 0; i < 4; ++i) { *(LAS v4u*)(UL + (i * 64 + lane) * 32) = uw[2 * i]; *(LAS v4u*)(UL + (i * 64 + lane) * 32 + 16) = uw[2 * i + 1]; } }
    const f32x2 a = *(const f32x2*)(abar + (size_t)((l * 64 + g) * 64 + lane) * 2);
    float sr = 0.f, si = 0.f;
    if (PASS_C) {
        float tr = a.x, ti = a.y;
#pragma unroll
        for (int k = 0; k < 8; ++k) { const float nr = tr * tr - ti * ti; ti = 2.f * tr * ti; tr = nr; }
        const float* sp = send + ((size_t)b * 1024 + g) * 128 + lane * 2;
        float pr = 1.f, pi = 0.f;
        f32x2 e[16];
#pragma unroll
        for (int k = 0; k < 16; ++k) { const int cp = c - 1 - k; e[k] = *(const f32x2*)(sp + (size_t)(cp < 0 ? 0 : cp) * 8192); if (cp < 0) e[k] = (f32x2){0.f, 0.f}; }
#pragma unroll
        for (int k = 0; k < 16; ++k) { sr += pr * e[k].x - pi * e[k].y; si += pr * e[k].y + pi * e[k].x; const float npr = pr * tr - pi * ti; pi = pr * ti + pi * tr; pr = npr; }
    }
    v2u bw[8];
#pragma unroll
    for (int nt = 0; nt < 8; ++nt) bw[nt] = *(const v2u*)(bbt + ((size_t)((l * 64 + g) * 128 + nt * 16 + c16)) * 16 + quad * 4);
    v4u cA[4];
    if (PASS_C) {
        const float* cr = cre + (size_t)((l * 64 + g) * 16 + c16) * 64 + quad * 4; const float* ci = cim + (size_t)((l * 64 + g) * 16 + c16) * 64 + quad * 4;
#pragma unroll
        for (int ks = 0; ks < 4; ++ks) { const f32x4 re = *(const f32x4*)(cr + ks * 16), im = *(const f32x4*)(ci + ks * 16);
            cA[ks] = (v4u){pk2(re.x, -im.x), pk2(re.y, -im.y), pk2(re.z, -im.z), pk2(re.w, -im.w)}; }
    }
    f32x4 dd = (f32x4){0.f, 0.f, 0.f, 0.f};
    if (PASS_C) dd = *(const f32x4*)(dvec + l * 1024 + g * 16 + quad * 4);
#pragma unroll 1
    for (int blk = 0; blk < nblk; ++blk) {
        const v2u ua = *(const LAS v2u*)(UL + (blk * 16 + c16) * 32 + quad * 8);
        const s16x4 ua4 = __builtin_bit_cast(s16x4, ua);
#if PROBE_D
#pragma unroll 1
        for (int rpd = 0; rpd < 3; ++rpd)
#endif
#pragma unroll
        for (int nt = 0; nt < 8; ++nt) { const pg8::f32x4 d = __builtin_amdgcn_mfma_f32_16x16x16bf16_1k(ua4, __builtin_bit_cast(s16x4, bw[nt]), (pg8::f32x4){0.f, 0.f, 0.f, 0.f}, 0, 0, 0);
#pragma unroll
            for (int j = 0; j < 4; ++j) BL[(quad * 4 + j) * 132 + nt * 16 + c16] = d[j]; }
        LDS_WAIT();
#if PROBE_S
        const float sr0 = sr, si0 = si;
#pragma unroll 1
        for (int rps = 0; rps < 3; ++rps) { sr = sr0; si = si0; asm volatile("" : "+v"(sr), "+v"(si));
            if (rps > 0) {
#pragma unroll
                for (int nt = 0; nt < 8; ++nt) { const pg8::f32x4 d = __builtin_amdgcn_mfma_f32_16x16x16bf16_1k(ua4, __builtin_bit_cast(s16x4, bw[nt]), (pg8::f32x4){0.f, 0.f, 0.f, 0.f}, 0, 0, 0);
#pragma unroll
                    for (int j = 0; j < 4; ++j) BL[(quad * 4 + j) * 132 + nt * 16 + c16] = d[j]; }
                LDS_WAIT(); }
#endif
        f32x2 bu[16];
#pragma unroll
        for (int t = 0; t < 16; ++t) bu[t] = *(const LAS f32x2*)(BL + t * 132 + 2 * lane);
        LDS_WAIT();
#pragma unroll
        for (int t = 0; t < 16; ++t) {
            const float nr = a.x * sr - a.y * si + bu[t].x; si = a.x * si + a.y * sr + bu[t].y; sr = nr;
            if (PASS_C) *(LAS f32x2*)(SL + t * 132 + 2 * lane) = (f32x2){sr, si}; }
#if PROBE_S
        LDS_WAIT(); }
#endif
        if (PASS_C) {
            LDS_WAIT();
            pg8::f32x4 yacc = (pg8::f32x4){0.f, 0.f, 0.f, 0.f};
#if PROBE_Y
#pragma unroll 1
            for (int rpy = 0; rpy < 3; ++rpy) { yacc = (pg8::f32x4){0.f, 0.f, 0.f, 0.f}; asm volatile("" : "+v"(yacc));
#endif
            f32x4 sv[8];
#pragma unroll
            for (int ks = 0; ks < 4; ++ks) { sv[2 * ks] = *(const LAS f32x4*)(SL + c16 * 132 + ks * 32 + quad * 8); sv[2 * ks + 1] = *(const LAS f32x4*)(SL + c16 * 132 + ks * 32 + quad * 8 + 4); }
            LDS_WAIT();
#pragma unroll
            for (int ks = 0; ks < 4; ++ks) { const v4u sb = (v4u){pk2(sv[2 * ks].x, sv[2 * ks].y), pk2(sv[2 * ks].z, sv[2 * ks].w), pk2(sv[2 * ks + 1].x, sv[2 * ks + 1].y), pk2(sv[2 * ks + 1].z, sv[2 * ks + 1].w)};
                yacc = __builtin_amdgcn_mfma_f32_16x16x32_bf16(__builtin_bit_cast(pg8::bf16x8, cA[ks]), __builtin_bit_cast(pg8::bf16x8, sb), yacc, 0, 0, 0); }
#if PROBE_Y
            }
#endif
            const float y0 = gelu_s(yacc[0] + dd.x * bflo(ua.x)), y1 = gelu_s(yacc[1] + dd.y * bfhi(ua.x)), y2 = gelu_s(yacc[2] + dd.z * bflo(ua.y)), y3 = gelu_s(yacc[3] + dd.w * bfhi(ua.y));
            v2u o; o.x = pk2(y0, y1); o.y = pk2(y2, y3);
            *(v2u*)(yg + (size_t)(tok0 + blk * 16 + c16) * 1024 + g * 16 + quad * 4) = o;
        }
        LDS_WAIT();
    }
    if (!PASS_C) *(f32x2*)(send + ((size_t)((b * 16 + c) * 64 + g) * 64 + lane) * 2) = (f32x2){sr, si};
}

__device__ __forceinline__ void attn_item(int item, int l, const bf16* proj, const float* qg, const float* kg, const float* sinks, bf16* ys1, LAS unsigned char* lds, int tid) {
    const int b = item >> 7, n = (item >> 2) & 31, kvh = item & 3;
    LAS unsigned char* KLb = lds;
    LAS unsigned short* VtL = (LAS unsigned short*)(lds + 36864);
    const int tokb = b * 4096 + n * 128 - 128;
#pragma unroll
    for (int i = 0; i < 4; ++i) {
        const int idx = tid + i * 512, row = idx >> 3, ch = idx & 7;
        v4u kw = (v4u){0u, 0u, 0u, 0u}, vw = (v4u){0u, 0u, 0u, 0u};
        if (n > 0 || row >= 128) { const bf16* kp = proj + (size_t)(tokb + row) * INC + C_K + kvh * 64 + ch * 8; kw = *(const v4u*)kp; vw = *(const v4u*)(kp + (C_V - C_K)); }
        float kf[8]; unpack8(kw, kf);
        float ss = 0.f;
#pragma unroll
        for (int e = 0; e < 8; ++e) ss += kf[e] * kf[e];
        ss += __shfl_xor(ss, 1); ss += __shfl_xor(ss, 2); ss += __shfl_xor(ss, 4);
        const float r = rsqrtf(ss * (1.f / 64.f) + EPS);
        const f32x4 g0 = *(const f32x4*)(kg + ch * 8), g1 = *(const f32x4*)(kg + ch * 8 + 4);
        kf[0] *= r * g0.x; kf[1] *= r * g0.y; kf[2] *= r * g0.z; kf[3] *= r * g0.w; kf[4] *= r * g1.x; kf[5] *= r * g1.y; kf[6] *= r * g1.z; kf[7] *= r * g1.w;
        *(LAS v4u*)(KLb + row * 144 + ch * 16) = pack8(kf);
#pragma unroll
        for (int e = 0; e < 8; ++e) VtL[(ch * 8 + e) * 264 + row] = (unsigned short)((vw[e >> 1] >> (16 * (e & 1))) & 0xffffu);
    }
    float gkmax = 0.f;
#pragma unroll 8
    for (int d = 0; d < 64; ++d) gkmax = fmaxf(gkmax, fabsf(kg[d]));
    const float LOG2E = 1.4426950408889634f;
    __syncthreads();
    const int lane = tid & 63, w = tid >> 6, c16 = lane & 15, quad = lane >> 4;
    const int g = w >> 1, tq0 = (w & 1) * 64, qh = kvh * 4 + g;
    const float sink2 = sinks[qh] * LOG2E;
#pragma unroll 1
    for (int qt = 0; qt < 4; ++qt) {
        const int tmin = tq0 + qt * 16, t = tmin + c16, tok = b * 4096 + n * 128 + t;
        float qv[16];
        { const bf16* qp = proj + (size_t)tok * INC + C_Q + qh * 64; unpack8(*(const v4u*)(qp + quad * 8), qv); unpack8(*(const v4u*)(qp + 32 + quad * 8), qv + 8); }
        float ss = 0.f;
#pragma unroll
        for (int e = 0; e < 16; ++e) ss += qv[e] * qv[e];
        ss += __shfl_xor(ss, 16); ss += __shfl_xor(ss, 32);
        const float r = rsqrtf(ss * (1.f / 64.f) + EPS) * (0.125f * LOG2E);
        float qn2 = 0.f;
#pragma unroll
        for (int e = 0; e < 8; ++e) { qv[e] *= r * qg[quad * 8 + e]; qv[8 + e] *= r * qg[32 + quad * 8 + e]; qn2 += qv[e] * qv[e] + qv[8 + e] * qv[8 + e]; }
        qn2 += __shfl_xor(qn2, 16); qn2 += __shfl_xor(qn2, 32);
        const float Mb2 = fmaxf(sqrtf(qn2) * 8.f * gkmax, sink2);
        pg8::bf16x8 qB[2];
        qB[0] = __builtin_bit_cast(pg8::bf16x8, pack8(qv)); qB[1] = __builtin_bit_cast(pg8::bf16x8, pack8(qv + 8));
        pg8::f32x4 oacc[4];
#pragma unroll
        for (int dt = 0; dt < 4; ++dt) oacc[dt] = (pg8::f32x4){0.f, 0.f, 0.f, 0.f};
        float lsum = 0.f;
        int p_lo = (tmin + 1) >> 5; const int p_hi = (tmin + 143) >> 5;
        if (n == 0 && p_lo < 4) p_lo = 4;
#pragma unroll 1
        for (int p = p_lo; p <= p_hi; ++p) {
            pg8::f32x4 sacc[2];
#pragma unroll
            for (int tt = 0; tt < 2; ++tt) { sacc[tt] = (pg8::f32x4){0.f, 0.f, 0.f, 0.f};
#pragma unroll
                for (int ks = 0; ks < 2; ++ks) { const pg8::bf16x8 a = *(const LAS pg8::bf16x8*)(KLb + ((2 * p + tt) * 16 + c16) * 144 + ks * 64 + quad * 16);
                    sacc[tt] = __builtin_amdgcn_mfma_f32_16x16x32_bf16(a, qB[ks], sacc[tt], 0, 0, 0); } }
            float pe[8];
#pragma unroll
            for (int tt = 0; tt < 2; ++tt)
#pragma unroll
                for (int j = 0; j < 4; ++j) { const int kb = (2 * p + tt) * 16 + quad * 4 + j; const bool valid = (kb >= t + 1) && (kb <= t + 128) && (n > 0 || kb >= 128);
                    const float pv = valid ? __builtin_amdgcn_exp2f(sacc[tt][j] - Mb2) : 0.f; pe[tt * 4 + j] = pv; lsum += pv; }
            const pg8::bf16x8 pb = __builtin_bit_cast(pg8::bf16x8, pack8(pe));
#pragma unroll
            for (int dt = 0; dt < 4; ++dt) { const LAS unsigned short* vp = VtL + (dt * 16 + c16) * 264 + p * 32 + quad * 4;
                const v2u lo = *(const LAS v2u*)vp, hi = *(const LAS v2u*)(vp + 16);
                const pg8::bf16x8 a = __builtin_bit_cast(pg8::bf16x8, (v4u){lo.x, lo.y, hi.x, hi.y});
                oacc[dt] = __builtin_amdgcn_mfma_f32_16x16x32_bf16(a, pb, oacc[dt], 0, 0, 0); }
        }
        lsum += __shfl_xor(lsum, 16); lsum += __shfl_xor(lsum, 32);
        const float inv = 1.f / (lsum + __builtin_amdgcn_exp2f(sink2 - Mb2));
        bf16* op = ys1 + (size_t)tok * 1024 + qh * 64 + quad * 4;
#pragma unroll
        for (int dt = 0; dt < 4; ++dt) { v2u o; o.x = pk2(oacc[dt][0] * inv, oacc[dt][1] * inv); o.y = pk2(oacc[dt][2] * inv, oacc[dt][3] * inv); *(v2u*)(op + dt * 16) = o; }
    }
    __syncthreads();
}

__device__ __forceinline__ void sgu_item(int item, int l, const bf16* proj, const float* lng, const float* lnb, const float* sw, const float* sb, bf16* ys2, LAS unsigned char* lds, int tid, int wave) {
    const int b = item >> 8, nc = (item >> 3) & 31, h = item & 7;
    const int tok0 = b * 4096 + nc * 128;
    LAS unsigned short* VnT = (LAS unsigned short*)lds;
    LAS unsigned short* Wb = (LAS unsigned short*)(lds + 34816);
    LAS float* ST = (LAS float*)(lds + 69632);
    { const int row = tid >> 2, q4 = tid & 3; const v4u* vp = (const v4u*)(proj + (size_t)(tok0 + row) * INC + C_SGU + 1024 + q4 * 256);
      float s1 = 0.f, s2 = 0.f;
#pragma unroll 8
      for (int i = 0; i < 32; ++i) { float f[8]; unpack8(vp[i], f);
#pragma unroll
          for (int e = 0; e < 8; ++e) { s1 += f[e]; s2 += f[e] * f[e]; } }
      s1 += __shfl_xor(s1, 1); s1 += __shfl_xor(s1, 2); s2 += __shfl_xor(s2, 1); s2 += __shfl_xor(s2, 2);
      const float mean = s1 * (1.f / 1024.f); const float var = fmaxf(s2 * (1.f / 1024.f) - mean * mean, 0.f);
      if (q4 == 0) { ST[row * 2] = mean; ST[row * 2 + 1] = rsqrtf(var + EPS); } }
#pragma unroll
    for (int i = 0; i < 8; ++i) { const int flat = (tid + i * 512) * 4, t = flat >> 7, s = flat & 127;
        f32x4 w = *(const f32x4*)(sw + ((size_t)((l * 8 + h) * 128 + t)) * 128 + s);
        w.x = (s <= t) ? w.x : 0.f; w.y = (s + 1 <= t) ? w.y : 0.f; w.z = (s + 2 <= t) ? w.z : 0.f; w.w = (s + 3 <= t) ? w.w : 0.f;
        v2u o; o.x = pk2(w.x, w.y); o.y = pk2(w.z, w.w); *(LAS v2u*)(Wb + t * 136 + s) = o; }
    __syncthreads();
#pragma unroll
    for (int i = 0; i < 4; ++i) { const int idx = tid + i * 512, s = idx >> 4, c = (idx & 15) * 8;
        float f[8]; unpack8(*(const v4u*)(proj + (size_t)(tok0 + s) * INC + C_SGU + 1024 + h * 128 + c), f);
        const float mean = ST[s * 2], rstd = ST[s * 2 + 1];
        const f32x4 g0 = *(const f32x4*)(lng + l * 1024 + h * 128 + c), g1 = *(const f32x4*)(lng + l * 1024 + h * 128 + c + 4);
        const f32x4 b0 = *(const f32x4*)(lnb + l * 1024 + h * 128 + c), b1 = *(const f32x4*)(lnb + l * 1024 + h * 128 + c + 4);
        float vn[8];
        vn[0] = (f[0] - mean) * rstd * g0.x + b0.x; vn[1] = (f[1] - mean) * rstd * g0.y + b0.y; vn[2] = (f[2] - mean) * rstd * g0.z + b0.z; vn[3] = (f[3] - mean) * rstd * g0.w + b0.w;
        vn[4] = (f[4] - mean) * rstd * g1.x + b1.x; vn[5] = (f[5] - mean) * rstd * g1.y + b1.y; vn[6] = (f[6] - mean) * rstd * g1.z + b1.z; vn[7] = (f[7] - mean) * rstd * g1.w + b1.w;
        const v4u pk = pack8(vn);
#pragma unroll
        for (int e = 0; e < 8; ++e) VnT[(c + e) * 136 + s] = (unsigned short)((pk[e >> 1] >> (16 * (e & 1))) & 0xffffu); }
    __syncthreads();
    const int lane = tid & 63, c16 = lane & 15, quad = lane >> 4;
    pg8::f32x4 acc[8];
#pragma unroll
    for (int mt = 0; mt < 8; ++mt) acc[mt] = (pg8::f32x4){0.f, 0.f, 0.f, 0.f};
    const int ks_end = (wave >> 1) + 1;
#pragma unroll 1
    for (int ks = 0; ks < ks_end; ++ks) {
        const pg8::bf16x8 bq = *(const LAS pg8::bf16x8*)((LAS unsigned char*)Wb + (wave * 16 + c16) * 272 + ks * 64 + quad * 16);
#pragma unroll
        for (int mt = 0; mt < 8; ++mt) { const pg8::bf16x8 aq = *(const LAS pg8::bf16x8*)((LAS unsigned char*)VnT + (mt * 16 + c16) * 272 + ks * 64 + quad * 16);
            acc[mt] = __builtin_amdgcn_mfma_f32_16x16x32_bf16(aq, bq, acc[mt], 0, 0, 0); }
    }
    const int t = wave * 16 + c16;
    const float bias = sb[(l * 8 + h) * 128 + t];
#pragma unroll
    for (int mt = 0; mt < 8; ++mt) { const int ch = h * 128 + mt * 16 + quad * 4; const v2u uw = *(const v2u*)(proj + (size_t)(tok0 + t) * INC + C_SGU + ch);
        v2u o; o.x = pk2(bflo(uw.x) * (acc[mt][0] + bias), bfhi(uw.x) * (acc[mt][1] + bias)); o.y = pk2(bflo(uw.y) * (acc[mt][2] + bias), bfhi(uw.y) * (acc[mt][3] + bias));
        *(v2u*)(ys2 + (size_t)(tok0 + t) * 1024 + ch) = o; }
    __syncthreads();
}

__device__ __forceinline__ unsigned xb_ld(unsigned* p);
__device__ __forceinline__ unsigned xb_add(unsigned* p, unsigned v);
constexpr int PEER_RB = 2;
__device__ __forceinline__ void peer_phase(int l, const float* scores, const bf16* xn, const unsigned char* P8U, const unsigned char* P8V, const float* scl, const float* rowss, const float* xio, float* xout, const float* gnext, bf16* hnext, bool has_next,
                                           LAS unsigned char* lds, int lane, int wave, int gw, int NGW, unsigned* lsync, unsigned nloc) {
    LAS int* EL = (LAS int*)(lds + wave * 8192); LAS float* GL = (LAS float*)(lds + wave * 8192 + 2048); LAS int* IL = (LAS int*)(lds + wave * 8192 + 4096);
    for (int wt = gw; wt < 2048; wt += NGW) {
        const int T0 = wt * 4;
#if PROBE_T
#pragma unroll 1
        for (int rpt = 0; rpt < 3; ++rpt)
#endif
        {
            int Kk[16];
#pragma unroll
            for (int j = 0; j < 16; ++j) Kk[j] = (int)0x80000000;
            const v4i* srow = (const v4i*)(scores + (size_t)T0 * 2048 + lane * 128);
#pragma unroll 1
            for (int i4 = 0; i4 < 32; ++i4) { const v4i v = srow[i4];
#pragma unroll
                for (int k = 0; k < 4; ++k) { int key = v[k]; key ^= (key >> 31) & 0x7fffffff; key = (key & ~127) | (127 - (i4 * 4 + k));
#pragma unroll
                    for (int j = 0; j < 16; ++j) { const int hi = max(Kk[j], key); key = min(Kk[j], key); Kk[j] = hi; } } }
            float Lv[16];
#pragma unroll
            for (int j = 0; j < 16; ++j) { IL[lane * 16 + j] = 127 - (Kk[j] & 127); int m = Kk[j] & ~127; m ^= (m >> 31) & 0x7fffffff; Lv[j] = __int_as_float(m); }
            const bool c0 = (lane & 1) == 0;
            float av[16], bv[16];
#pragma unroll
            for (int j = 0; j < 16; ++j) { const float pv = __shfl_xor(Lv[j], 1); av[j] = c0 ? Lv[j] : pv; bv[j] = c0 ? pv : Lv[j]; }
#define CKEY(i, j) ({ int _k = __float_as_int(av[i] + bv[j]); _k ^= (_k >> 31) & 0x7fffffff; (_k & ~255) | (255 - ((i) * 16 + (j))); })
            int Ck[16];
#pragma unroll
            for (int j = 0; j < 16; ++j) Ck[j] = CKEY(0, j);
#define CAND(i, j) do { int _key = CKEY(i, j); _Pragma("unroll") for (int _j = 0; _j < 16; ++_j) { const int _hi = max(Ck[_j], _key); _key = min(Ck[_j], _key); Ck[_j] = _hi; } } while (0)
            CAND(1, 0); CAND(1, 1); CAND(1, 2); CAND(1, 3); CAND(1, 4); CAND(1, 5); CAND(1, 6); CAND(1, 7);
            CAND(2, 0); CAND(2, 1); CAND(2, 2); CAND(2, 3); CAND(2, 4);
            CAND(3, 0); CAND(3, 1); CAND(3, 2); CAND(3, 3);
            CAND(4, 0); CAND(4, 1); CAND(4, 2);
            CAND(5, 0); CAND(5, 1); CAND(6, 0); CAND(6, 1); CAND(7, 0); CAND(7, 1);
            CAND(8, 0); CAND(9, 0); CAND(10, 0); CAND(11, 0); CAND(12, 0); CAND(13, 0); CAND(14, 0); CAND(15, 0);
#undef CAND
#undef CKEY
            LDS_WAIT();
            float ex[16]; float sum = 0.f; float cv0 = 0.f;
#pragma unroll
            for (int k = 0; k < 16; ++k) { int m = Ck[k] & ~255; m ^= (m >> 31) & 0x7fffffff; const float cv = __int_as_float(m); if (k == 0) cv0 = cv; ex[k] = __builtin_amdgcn_exp2f((cv - cv0) * 1.4426950408889634f); sum += ex[k]; }
            const float inv = 1.f / sum;
            if (c0) { const int slot = (lane >> 1) * 16;
#pragma unroll
                for (int k = 0; k < 16; ++k) { const int code = 255 - (Ck[k] & 255); const int e1 = IL[lane * 16 + (code >> 4)], e2 = IL[(lane + 1) * 16 + (code & 15)];
                    EL[slot + k] = e1 * 128 + e2; GL[slot + k] = ex[k] * inv; } }
            LDS_WAIT();
        }
        {
            LAS int* ES = IL; LAS float* GS = (LAS float*)(IL + 512);
#pragma unroll 1
            for (int tl = 0; tl < 4; ++tl) {
                const int e0 = EL[tl * 128 + lane], e1 = EL[tl * 128 + 64 + lane]; const float g0 = GL[tl * 128 + lane], g1 = GL[tl * 128 + 64 + lane];
                int r0 = 0, r1 = 0;
#pragma unroll 4
                for (int j4 = 0; j4 < 32; ++j4) { const v4i ej = *(const LAS v4i*)(EL + tl * 128 + j4 * 4);
#pragma unroll
                    for (int k = 0; k < 4; ++k) { const int j = j4 * 4 + k;
                        r0 += ((ej[k] < e0) || (ej[k] == e0 && j < lane)) ? 1 : 0; r1 += ((ej[k] < e1) || (ej[k] == e1 && j < lane + 64)) ? 1 : 0; } }
                ES[tl * 128 + r0] = e0; GS[tl * 128 + r0] = g0; ES[tl * 128 + r1] = e1; GS[tl * 128 + r1] = g1;
            }
            LDS_WAIT();
        }
#pragma unroll 1
        for (int tl = 0; tl < 4; ++tl) {
            if (NGW == 2048) __syncthreads();
            const int tok = T0 + tl;
            const float rstd_t = rsqrtf(wave_sum(lane < 32 ? rowss[(size_t)tok * 32 + lane] : 0.f) * (1.f / 2048.f) + EPS);
            float xf[32];
            { const v4u* xp = (const v4u*)(xn + (size_t)tok * 2048);
#pragma unroll
              for (int j = 0; j < 2; ++j) { unpack8(xp[j * 128 + lane * 2], xf + j * 16); unpack8(xp[j * 128 + lane * 2 + 1], xf + j * 16 + 8); } }
            float out[32];
#pragma unroll
            for (int i = 0; i < 32; ++i) out[i] = 0.f;
#define PEER_LOAD(KB, UW, VW, SU, SV, GT) do { \
                _Pragma("unroll") for (int r = 0; r < PEER_RB; ++r) { const int e_ = __builtin_amdgcn_readfirstlane(IL[tl * 128 + (KB) * PEER_RB + r]); GT[r] = ((LAS float*)(IL + 512))[tl * 128 + (KB) * PEER_RB + r]; \
                    const v4u* up = (const v4u*)(P8U + ((size_t)l * 16384 + e_) * 2048); UW[r][0] = up[lane]; UW[r][1] = up[64 + lane]; SU[r] = scl[l * 16384 + e_]; \
                    const v4u* vp = (const v4u*)(P8V + ((size_t)l * 16384 + e_) * 2048); VW[r][0] = vp[lane]; VW[r][1] = vp[64 + lane]; SV[r] = scl[32768 + l * 16384 + e_]; } } while (0)
#define PEER_COMPUTE(UW, VW, SU, SV, GT) do { float hs[PEER_RB]; \
                _Pragma("unroll") for (int r = 0; r < PEER_RB; ++r) { float s0 = 0.f, s1 = 0.f; \
                    _Pragma("unroll") for (int j = 0; j < 2; ++j) _Pragma("unroll") for (int q = 0; q < 4; ++q) { const int w = (int)UW[r][j][q]; const f32x2 lo = __builtin_amdgcn_cvt_pk_f32_fp8(w, false), hi = __builtin_amdgcn_cvt_pk_f32_fp8(w, true); const float* x = xf + j * 16 + q * 4; \
                        s0 += lo.x * x[0]; s1 += lo.y * x[1]; s0 += hi.x * x[2]; s1 += hi.y * x[3]; } \
                    hs[r] = s0 + s1; } \
                _Pragma("unroll") for (int o = 1; o < 64; o <<= 1) { _Pragma("unroll") for (int r = 0; r < PEER_RB; ++r) hs[r] += __shfl_xor(hs[r], o); } \
                _Pragma("unroll") for (int r = 0; r < PEER_RB; ++r) { const float a = gelu_s(hs[r] * (SU[r] * rstd_t)) * GT[r] * SV[r]; \
                    _Pragma("unroll") for (int j = 0; j < 2; ++j) _Pragma("unroll") for (int q = 0; q < 4; ++q) { const int w = (int)VW[r][j][q]; const f32x2 lo = __builtin_amdgcn_cvt_pk_f32_fp8(w, false), hi = __builtin_amdgcn_cvt_pk_f32_fp8(w, true); float* o = out + j * 16 + q * 4; \
                        o[0] += a * lo.x; o[1] += a * lo.y; o[2] += a * hi.x; o[3] += a * hi.y; } } } while (0)
            {
                v4u uwA[PEER_RB][2], vwA[PEER_RB][2], uwB[PEER_RB][2], vwB[PEER_RB][2]; float suA[PEER_RB], svA[PEER_RB], gtA[PEER_RB], suB[PEER_RB], svB[PEER_RB], gtB[PEER_RB];
                PEER_LOAD(0, uwA, vwA, suA, svA, gtA);
#pragma unroll 1
                for (int kb2 = 0; kb2 < 128 / PEER_RB / 2; ++kb2) {
                    PEER_LOAD(2 * kb2 + 1, uwB, vwB, suB, svB, gtB);
                    PEER_COMPUTE(uwA, vwA, suA, svA, gtA);
                    if (kb2 + 1 < 128 / PEER_RB / 2) PEER_LOAD(2 * kb2 + 2, uwA, vwA, suA, svA, gtA);
                    PEER_COMPUTE(uwB, vwB, suB, svB, gtB);
                }
            }
#undef PEER_LOAD
#undef PEER_COMPUTE
            const float* xr = xio + (size_t)tok * 2048; float* xw = xout + (size_t)tok * 2048; float ss = 0.f;
#pragma unroll
            for (int j = 0; j < 2; ++j)
#pragma unroll
                for (int q = 0; q < 4; ++q) { const f32x4* p = (const f32x4*)xr + j * 256 + lane * 4 + q; f32x4* pw = (f32x4*)xw + j * 256 + lane * 4 + q; f32x4 p0 = *p;
#pragma unroll
                    for (int e2 = 0; e2 < 4; ++e2) { p0[e2] += out[j * 16 + q * 4 + e2]; out[j * 16 + q * 4 + e2] = p0[e2]; ss += p0[e2] * p0[e2]; }
                    *pw = p0; }
            if (has_next) { const float rstd = rsqrtf(wave_sum(ss) * (1.f / 2048.f) + EPS);
#pragma unroll
                for (int j = 0; j < 2; ++j) { float v[16];
#pragma unroll
                    for (int q = 0; q < 4; ++q) { const f32x4 g4 = ((const f32x4*)gnext)[j * 256 + lane * 4 + q];
#pragma unroll
                        for (int e2 = 0; e2 < 4; ++e2) v[q * 4 + e2] = out[j * 16 + q * 4 + e2] * rstd * g4[e2]; }
                    ((v4u*)(hnext + (size_t)tok * 2048))[j * 128 + lane * 2] = pack8(v); ((v4u*)(hnext + (size_t)tok * 2048))[j * 128 + lane * 2 + 1] = pack8(v + 8); } }
        }
        LDS_WAIT();
    }
}

#define XB_TMO      128
#define XB_XCNT(j)  (256  + 64 * (j))
#define XB_XSUB(j)  (1280 + 64 * (j))
#define XB_XGEN(j)  (2304 + 64 * (j))
#define XB_TOP      3328
#define XB_TOPGEN   3392
#define XCD_BAR_WORDS 3456
#define XB_SPIN_CAP (1u << 18)

__device__ __forceinline__ unsigned xb_ld(unsigned* p)              { return __hip_atomic_load(p, __ATOMIC_RELAXED, __HIP_MEMORY_SCOPE_AGENT); }
__device__ __forceinline__ unsigned xb_add(unsigned* p, unsigned v) { return __hip_atomic_fetch_add(p, v, __ATOMIC_RELAXED, __HIP_MEMORY_SCOPE_AGENT); }
__device__ __forceinline__ unsigned xb_xcc_id() { return (unsigned)__builtin_amdgcn_s_getreg((3 << 11) | 20) & 0xFu; }
#define XB_SPIN(cond, bar) do { unsigned _sp = 0; while (cond) { __builtin_amdgcn_s_sleep(1); \
    if ((++_sp & 255u) == 0u) { if (xb_ld(&(bar)[XB_TMO])) break; if (_sp > XB_SPIN_CAP) { atomicAdd(&(bar)[XB_TMO], 1u); break; } } } } while (0)

struct XcdBarrier {
    unsigned* bar; unsigned x;
    volatile LAS unsigned* st;
};

__device__ __forceinline__ XcdBarrier xcd_barrier_post(unsigned* bar, volatile LAS unsigned* st) {
    XcdBarrier b; b.bar = bar; b.x = xb_xcc_id(); b.st = st;
    if (threadIdx.x == 0) (void)xb_add(&bar[XB_XCNT(b.x)], 1u);
    return b;
}
__device__ __forceinline__ void xcd_barrier_complete(unsigned* bar, unsigned x, unsigned& nloc, unsigned& nx) {
    const unsigned G = gridDim.x * gridDim.y * gridDim.z;
    unsigned sum, cnt, mine, sp = 0u;
    for (;;) {
        sum = 0u; cnt = 0u; mine = 0u;
#pragma unroll
        for (unsigned j = 0; j < 16; ++j) { const unsigned c = xb_ld(&bar[XB_XCNT(j)]); sum += c; cnt += (c > 0u) ? 1u : 0u; mine = (j == x) ? c : mine; }
        if (sum == G) break;
        __builtin_amdgcn_s_sleep(1);
        if ((++sp & 255u) == 0u) { if (xb_ld(&bar[XB_TMO])) break; if (sp > XB_SPIN_CAP) { atomicAdd(&bar[XB_TMO], 1u); break; } }
    }
    nloc = mine > 0u ? mine : 1u; nx = cnt > 0u ? cnt : 1u;
}

__device__ __forceinline__ void xcd_barrier(const XcdBarrier& b) {
    asm volatile("s_waitcnt vmcnt(0)" ::: "memory");
    __syncthreads();
    if (threadIdx.x == 0) {
        unsigned* bar = b.bar;
        __builtin_amdgcn_s_waitcnt(0);
        unsigned nloc = b.st[0], nx = b.st[1];
        if (nloc == 0u) { xcd_barrier_complete(bar, b.x, nloc, nx); b.st[0] = nloc; b.st[1] = nx; }
        const unsigned old = xb_add(&bar[XB_XSUB(b.x)], 1u);
        const unsigned gen = old / nloc;
        if (old + 1u == (gen + 1u) * nloc) {
            __builtin_amdgcn_fence(__ATOMIC_RELEASE, "agent");
            asm volatile("s_waitcnt vmcnt(0)" ::: "memory");
            const unsigned og = xb_add(&bar[XB_TOP], 1u);
            const unsigned tg = og / nx;
            if (og + 1u == (tg + 1u) * nx) xb_add(&bar[XB_TOPGEN], 1u);
            else XB_SPIN(xb_ld(&bar[XB_TOPGEN]) == tg, bar);
            __builtin_amdgcn_fence(__ATOMIC_ACQUIRE, "agent");
            xb_add(&bar[XB_XGEN(b.x)], 1u);
            asm volatile("s_waitcnt vmcnt(0)" ::: "memory");
        } else {
            XB_SPIN(xb_ld(&bar[XB_XGEN(b.x)]) == gen, bar);
            __builtin_amdgcn_fence(__ATOMIC_ACQUIRE, "agent");
            asm volatile("s_waitcnt vmcnt(0)" ::: "memory");
        }
    }
    __syncthreads();
}

struct Args { const float* in[27]; float* out; unsigned char* ws; int ph_lo, ph_hi; };
__global__ void __launch_bounds__(NTHR, 2) hybrid_fwd(Args args) {
    extern __shared__ __attribute__((aligned(16))) unsigned char lds_raw[];
    LAS unsigned char* lds = (LAS unsigned char*)lds_raw;
    cg::grid_group grid = cg::this_grid();
    const int G = gridDim.x, NGW = G * 8;
    unsigned char* ws = args.ws;
    float* abar = (float*)(ws + WS_ABAR); bf16* bbt = (bf16*)(ws + WS_BBAR); float* send = (float*)(ws + WS_SEND);
    bf16* Win_t = (bf16*)(ws + WS_WIN); bf16* Wglu_t = (bf16*)(ws + WS_WGLU); bf16* Wbr_t = (bf16*)(ws + WS_WBR); bf16* Wout_t = (bf16*)(ws + WS_WOUT); bf16* Wqk_t = (bf16*)(ws + WS_WQK);
    unsigned char* P8U = ws + WS_PU; unsigned char* P8V = ws + WS_PV; float* scl = (float*)(ws + WS_SCL); float* rowss = (float*)(ws + WS_MTMP); bf16* hbuf = (bf16*)(ws + WS_H); bf16* xnbuf = (bf16*)(ws + WS_XN); bf16* proj = (bf16*)(ws + WS_PROJ);
    bf16* yg = (bf16*)(ws + WS_YG); bf16* ys = (bf16*)(ws + WS_YS); float* mtmp = (float*)(ws + WS_MTMP); bf16* merged = (bf16*)(ws + WS_MERGED); float* scores = (float*)(ws + WS_SCORES);

    volatile LAS unsigned* bst = (volatile LAS unsigned*)(lds + LDS_BYTES - 16);
    if (threadIdx.x < 4) bst[threadIdx.x] = 0u;
    __syncthreads();
    XcdBarrier xbar; xbar.bar = (unsigned*)ws; xbar.x = 0; xbar.st = bst;
    if (args.ph_hi - args.ph_lo > 1) xbar = xcd_barrier_post((unsigned*)ws, bst);
    for (int ph = args.ph_lo; ph < args.ph_hi; ++ph) {
        if (ph > args.ph_lo) { asm volatile("s_waitcnt vmcnt(0)" ::: "memory"); if (ph == args.ph_lo + 1) grid.sync(); else xcd_barrier(xbar);
#if REP_SYNC
            for (int q = 0; q < REP_SYNC; ++q) xcd_barrier(xbar);
#endif
        }
        int nrep = 1;
#if REP_MASK
        { const int key = ph == 0 ? 0 : 1 + (ph - 1) % 8; nrep = ((REP_MASK >> key) & 1) ? 2 : 1; }
#endif
#if REP_MASK
        for (int rep = 0; rep < nrep; ++rep)
#else
        const int rep = 0;
#endif
        {
        int tid_o = threadIdx.x, bx_o = blockIdx.x; asm volatile("" : "+v"(tid_o), "+s"(bx_o));
        const int tid = tid_o, bx = bx_o, lane = tid & 63, wave = __builtin_amdgcn_readfirstlane(tid >> 6), gw = bx * 8 + wave;
        if (ph == 0) {
#if (PH_ON & 1)
#pragma unroll 1
            for (int stage = 0; stage < 2; ++stage) {
            if (stage == ((bx & 1) ? 0 : 1)) {
            { LAS float* KL = (LAS float*)lds; LAS float* WL = (LAS float*)(lds + 128 * 132 * 4);
              for (int it = bx; it < 2 * 512; it += G) { const int l = it >> 9, b16 = (it >> 5) & 15, kk0 = (it & 31) * 64; const int hh = b16 >> 1, cc = b16 & 1;
                  const float* kp = args.in[24] + ((size_t)((l * 2 + cc) * 8 + hh)) * 128 * 128; const float* wq = args.in[23] + (size_t)l * 2048 * 2048;
#pragma unroll
                  for (int i = 0; i < 8; ++i) { const int flat = (tid + i * 512) * 4, row = flat >> 7, col = flat & 127; *(LAS f32x4*)(KL + row * 132 + col) = *(const f32x4*)(kp + flat); }
#pragma unroll
                  for (int i = 0; i < 4; ++i) { const int flat = (tid + i * 512) * 4, row = flat >> 7, col = flat & 127; *(LAS f32x4*)(WL + row * 132 + col) = *(const f32x4*)(wq + (size_t)(kk0 + row) * 2048 + b16 * 128 + col); }
                  __syncthreads();
                  const int n = tid & 127, kg = tid >> 7; float acc[16];
#pragma unroll
                  for (int j = 0; j < 16; ++j) acc[j] = 0.f;
#pragma unroll 2
                  for (int d4 = 0; d4 < 32; ++d4) { const f32x4 kv = *(const LAS f32x4*)(KL + n * 132 + d4 * 4);
#pragma unroll
                      for (int j = 0; j < 16; ++j) { const f32x4 wv = *(const LAS f32x4*)(WL + (kg * 16 + j) * 132 + d4 * 4); acc[j] += (kv.x * wv.x + kv.y * wv.y) + (kv.z * wv.z + kv.w * wv.w); } }
                  bf16* op = Wqk_t + (size_t)l * 2048 * 2048 + (size_t)(b16 * 128 + n) * 2048 + kk0 + kg * 16;
                  *(v4u*)op = pack8(acc); *(v4u*)(op + 8) = pack8(acc + 8);
                  __syncthreads(); } }
            }
            __syncthreads();
            if (stage == 0) {
            { LAS float* scr = (LAS float*)(lds + wave * 16384);
              for (int it = gw; it < 2 * 16384; it += NGW) { const int l = it >> 14; int r = it & 16383;
                  if (r < 10752) { p0_transpose_item(args.in[2] + (size_t)l * 2048 * INC, 2048, INC, Win_t + (size_t)l * INC * 2048, scr, r, lane); continue; } r -= 10752;
                  if (r < 512) { p0_transpose_item(args.in[11] + (size_t)l * 1024 * 1024, 1024, 1024, Wglu_t + (size_t)l * 1024 * 1024, scr, r, lane); continue; } r -= 512;
                  if (r < 3072) { const int n = r >> 10; r &= 1023; p0_transpose_item(args.in[20] + (size_t)(l * 3 + n) * 1024 * 2048, 1024, 2048, Wbr_t + (size_t)(l * 3 + n) * 2048 * 1024, scr, r, lane); continue; } r -= 3072;
                  p0_transpose_item(args.in[21] + (size_t)l * 2048 * 2048, 2048, 2048, Wout_t + (size_t)l * 2048 * 2048, scr, r, lane); } }
            { const size_t gt = (size_t)bx * NTHR + tid;
              { f32x4 vnx[2][4];
                { const int tsel = gw >> 15, within = gw & 32767; const f32x4* src = (const f32x4*)((tsel ? args.in[26] : args.in[25]) + (size_t)within * 2048);
#pragma unroll
                  for (int j = 0; j < 2; ++j)
#pragma unroll
                      for (int q = 0; q < 4; ++q) vnx[j][q] = src[j * 256 + lane * 4 + q]; }
                for (int r = gw; r < 65536; r += NGW) { const int tsel = r >> 15, within = r & 32767;
                  f32x4 v[2][4]; float mx = 0.f;
#pragma unroll
                  for (int j = 0; j < 2; ++j)
#pragma unroll
                      for (int q = 0; q < 4; ++q) v[j][q] = vnx[j][q];
                  { const int rn = (r + NGW < 65536) ? r + NGW : r; const f32x4* srcn = (const f32x4*)(((rn >> 15) ? args.in[26] : args.in[25]) + (size_t)(rn & 32767) * 2048);
#pragma unroll
                    for (int j = 0; j < 2; ++j)
#pragma unroll
                        for (int q = 0; q < 4; ++q) vnx[j][q] = srcn[j * 256 + lane * 4 + q]; }
#pragma unroll
                  for (int j = 0; j < 2; ++j)
#pragma unroll
                      for (int q = 0; q < 4; ++q) mx = fmaxf(mx, fmaxf(fmaxf(fabsf(v[j][q].x), fabsf(v[j][q].y)), fmaxf(fabsf(v[j][q].z), fabsf(v[j][q].w))));
#pragma unroll
                  for (int o = 1; o < 64; o <<= 1) mx = fmaxf(mx, __shfl_xor(mx, o));
                  mx = fmaxf(mx, 1e-30f); const float qs = 440.f / mx;
#pragma unroll
                  for (int j = 0; j < 2; ++j) { v4u o;
#pragma unroll
                      for (int q = 0; q < 4; ++q) { int w = __builtin_amdgcn_cvt_pk_fp8_f32(v[j][q].x * qs, v[j][q].y * qs, 0, false); w = __builtin_amdgcn_cvt_pk_fp8_f32(v[j][q].z * qs, v[j][q].w * qs, w, true); o[q] = (unsigned)w; }
                      ((v4u*)((tsel ? P8V : P8U) + (size_t)within * 2048))[j * 64 + lane] = o; }
                  if (lane == 0) scl[r] = mx * (1.f / 440.f); } }
              if (gt < 8192) {
                  const int idx = (int)gt, lg = idx >> 6;
                  const float are = args.in[3][idx], aim = args.in[4][idx], dt = expf(args.in[10][lg]);
                  const float er = expf(are * dt), ang = aim * dt; const float abr = er * cosf(ang), abi = er * sinf(ang);
                  abar[idx * 2] = abr; abar[idx * 2 + 1] = abi;
                  const float nr = abr - 1.f, ni = abi, den = are * are + aim * aim; const float cr = (nr * are + ni * aim) / den, ci = (ni * are - nr * aim) / den;
                  for (int h = 0; h < 16; ++h) { const float br = args.in[5][(size_t)idx * 16 + h], bi = args.in[6][(size_t)idx * 16 + h];
                      const float bre = cr * br - ci * bi, bim = cr * bi + ci * br; const size_t kb = ((size_t)lg * 128 + 2 * (idx & 63)) * 16 + h;
                      bbt[kb] = (bf16)(pk2(bre, 0.f) & 0xffffu); bbt[kb + 16] = (bf16)(pk2(bim, 0.f) & 0xffffu); } } }
            }
            __syncthreads();
            }
            for (int m = gw; m < M; m += NGW) rms_row_to_bf16(args.in[0] + (size_t)m * D, args.in[1], hbuf + (size_t)m * D, lane);
#endif
        } else {
        const int l = (ph - 1) / 8, sub = (ph - 1) % 8;
        bf16* ys0 = ys; bf16* ys1 = ys + (size_t)M * 1024; bf16* ys2 = ys + (size_t)2 * M * 1024;
        if (sub == 0 && (PH_ON & 2)) {
            pg8::Gemm g{hbuf, Win_t + (size_t)l * INC * 2048, M, INC, 2048}; RangeOrder S; S.base.init(M, INC, G, 0); S.lo = 0; S.hi = (G == 256) ? 1280 : 1344; S.G2 = G; S.c2 = bx;
            EpiProj E{proj}; pg8::gemm_phase<EpiProj, RangeOrder, true, true>(lds, g, S, E);
        } else if (sub == 1 && (PH_ON & 4)) {
            for (int rp = 0; rp < ((REP_MIX & 1) ? 2 : 1); ++rp)
            for (int it = bx; it < 256; it += G) attn_item(it, l, proj, args.in[13] + l * 64, args.in[14] + l * 64, args.in[15] + l * 16, ys1, lds, tid);
            for (int rp = 0; rp < ((REP_MIX & 2) ? 2 : 1); ++rp)
            for (int it = bx; it < 512; it += G) sgu_item(it, l, proj, args.in[16], args.in[17], args.in[18], args.in[19], ys2, lds, tid, wave);
            for (int rp = 0; rp < ((REP_MIX & 4) ? 2 : 1); ++rp)
            for (int it = bx; it < 256; it += G) ssm_item<false>(it, l, proj, abar, bbt, args.in[7], args.in[8], args.in[9], send, yg, lds, tid, lane, wave);
        } else if (sub == 2 && (PH_ON & 8)) {
#if PROBE_P
            for (int rpp = 0; rpp < 4; ++rpp)
            for (int it = bx; it < 256; it += G) ssm_item<true>(it, l, proj, abar, bbt, args.in[7], args.in[8], args.in[9], send, yg, lds, tid, lane, wave, 0);
#endif
            for (int it = bx; it < 256; it += G) ssm_item<true>(it, l, proj, abar, bbt, args.in[7], args.in[8], args.in[9], send, yg, lds, tid, lane, wave);
        } else if (sub == 3 && (PH_ON & 16)) {
            pg8::Gemm g{yg, Wglu_t + (size_t)l * 1024 * 1024, M, 1024, 1024}; pg8::StaticOrder S; S.init(M, 1024, G, bx);
            EpiGlu E{yg, args.in[12] + l * 1024, ys0}; pg8::gemm_phase<EpiGlu, pg8::StaticOrder, true, true>(lds, g, S, E);
            if (G == 256) {
                pg8::Gemm g2{hbuf, Win_t + (size_t)l * INC * 2048, M, INC, 2048}; RangeOrder S2; S2.base.init(M, INC, G, 0); S2.lo = 1280; S2.hi = 1344; S2.G2 = G; S2.c2 = (bx + 128) & 255;
                EpiProj E2{proj}; pg8::gemm_phase<EpiProj, RangeOrder, true, true>(lds, g2, S2, E2); }
        } else if (sub == 4 && (PH_ON & 32)) {
            pg8::Gemm g{ys, Wbr_t + (size_t)l * 3 * 2048 * 1024, 3 * M, 3 * 2048, 1024}; BranchOrder S{G, bx};
            EpiBranch E{proj, merged}; pg8::gemm_phase<EpiBranch, BranchOrder, true, true>(lds, g, S, E);
        } else if (sub == 5 && (PH_ON & 64)) {
            pg8::Gemm g{merged, Wout_t + (size_t)l * 2048 * 2048, M, 2048, 2048}; pg8::StaticOrder S; S.init(M, 2048, G, bx);
            EpiResidNorm E{l == 0 ? args.in[0] : (const float*)args.out, args.out, args.in[22] + l * D, xnbuf, rowss + (size_t)l * M * 32}; pg8::gemm_phase<EpiResidNorm, pg8::StaticOrder, true, true>(lds, g, S, E);
        } else if (sub == 6 && (PH_ON & 256)) {
            pg8::Gemm g{xnbuf, Wqk_t + (size_t)l * 2048 * 2048, M, 2048, 2048}; pg8::StaticOrder S; S.init(M, 2048, G, bx);
            EpiScoreF32 E{scores, rowss + (size_t)l * M * 32}; pg8::gemm_phase<EpiScoreF32, pg8::StaticOrder, true, true>(lds, g, S, E);
        } else if (PH_ON & 512) {
            const bool dry = rep + 1 < nrep;
            peer_phase(l, scores, xnbuf, P8U, P8V, scl, rowss + (size_t)l * M * 32, args.out, dry ? mtmp : args.out, args.in[1] + (l + 1 < DEPTH ? (l + 1) * D : 0), dry ? merged : hbuf, l + 1 < DEPTH, lds, lane, wave, gw, NGW, (unsigned*)ws + 4096 + 64 * xbar.x, bst[0] ? bst[0] : 1u);
        }
        }
        __syncthreads();
        }
    }
}

extern "C" void kernel_launch(void* const* d_in, const int* in_sizes, int n_in, void* d_out, int out_size, void* d_ws, size_t ws_size, hipStream_t stream) {
    static int grid = 0;
    if (grid == 0) {
        if (n_in != 27 || out_size != M * D || ws_size < WS_END) { fprintf(stderr, "kernel_launch: unexpected shapes (n_in %d out %d ws %zu)\n", n_in, out_size, ws_size); grid = -1; return; }
        int dev = 0, cus = 0, per_cu = 0;
        (void)hipGetDevice(&dev); (void)hipDeviceGetAttribute(&cus, hipDeviceAttributeMultiprocessorCount, dev);
        if (hipFuncSetAttribute((const void*)hybrid_fwd, hipFuncAttributeMaxDynamicSharedMemorySize, LDS_BYTES) != hipSuccess) { fprintf(stderr, "kernel_launch: hipFuncSetAttribute failed\n"); grid = -1; return; }
        if (hipOccupancyMaxActiveBlocksPerMultiprocessor(&per_cu, (const void*)hybrid_fwd, NTHR, LDS_BYTES) != hipSuccess || per_cu < 1) { fprintf(stderr, "kernel_launch: occupancy query failed (%d)\n", per_cu); (void)hipGetLastError(); grid = -1; return; }
        grid = cus * per_cu;
    }
    if (grid < 0) return;
    Args a{};
    for (int i = 0; i < 27; ++i) a.in[i] = (const float*)d_in[i];
    a.out = (float*)d_out; a.ws = (unsigned char*)d_ws;
#if N_LAUNCH_MODE == 1
    a.ph_lo = 0; a.ph_hi = NPHASE;
    if (hipMemsetAsync(d_ws, 0, 131072, stream) != hipSuccess) { fprintf(stderr, "kernel_launch: hipMemsetAsync failed\n"); return; }
    void* kargs[] = {&a};
    hipError_t e = hipLaunchCooperativeKernel((const void*)hybrid_fwd, dim3(grid), dim3(NTHR), kargs, LDS_BYTES, stream);
    if (e != hipSuccess) fprintf(stderr, "kernel_launch: cooperative launch failed: %s (grid %d)\n", hipGetErrorString(e), grid);
#else
    (void)hipMemsetAsync(d_ws, 0, 131072, stream);
    for (int ph = 0; ph < NPHASE; ++ph) { a.ph_lo = ph; a.ph_hi = ph + 1; hipLaunchKernelGGL(hybrid_fwd, dim3(grid), dim3(NTHR), LDS_BYTES, stream, a); }
#endif
}
```

```cpp
#include <hip/hip_runtime.h>
#include <hip/hip_cooperative_groups.h>
#include <cstdio>
#include <cstdint>
namespace cg = cooperative_groups;
#define N_LAUNCH_MODE 1
namespace pg8 {
#define PG8_LAS __attribute__((address_space(3)))
typedef unsigned short bf16_t;
typedef short bf16x8 __attribute__((ext_vector_type(8)));
typedef float f32x4 __attribute__((ext_vector_type(4)));
typedef unsigned u32x4 __attribute__((ext_vector_type(4)));
constexpr int BM = 256, BK = 64, HALF = 128, HTB = HALF * BK * 2  , STAGE_BYTES = 8 * HTB, NXCD = 8, WGM = 8;

__host__ __device__ __forceinline__ int lds_byte(int r, int c) { const int st = (r >> 4) * 2 + (c >> 5), rr = r & 15, cc = c & 31, ob = rr * 64 + cc * 2; return st * 1024 + (ob ^ (((ob >> 9) & 1) << 5)); }
__host__ __device__ __forceinline__ void stage_rc(int b, int& R, int& C) { const int st = b / 1024, sb = b % 1024, swz = sb ^ (((sb >> 9) & 1) << 5); R = (st >> 1) * 16 + swz / 64; C = (st & 1) * 32 + (swz % 64) / 2; }
__host__ __device__ __forceinline__ int perm32(int rho) { const int n = rho >> 4, i = rho & 15; return 8 * (i >> 2) + 4 * n + (i & 3); }

struct Unit { int pm, pn; };
struct Gemm { const bf16_t* A; const bf16_t* Bt; int M, N, K; };

struct StaticOrder {
    int nM, nN, nwg, G, c;
    __host__ __device__ void init(int M, int N, int G_, int c_) { nM = M / BM; nN = N / BM; nwg = nM * nN; G = G_; c = c_; }
    __host__ __device__ bool next(int i, Unit& u) const {
        const long L = (long)i * G + c; if (L >= nwg) return false;
        int wgid = (int)L; { const int q = nwg / NXCD, r = nwg % NXCD, xcd = wgid % NXCD, off = wgid / NXCD; wgid = (xcd < r ? xcd * (q + 1) : r * (q + 1) + (xcd - r) * q) + off; }
        const int nig = WGM * nN, gid = wgid / nig, fm = gid * WGM, gsz = (nM - fm) < WGM ? (nM - fm) : WGM;
        u.pm = fm + ((wgid % nig) % gsz); u.pn = (wgid % nig) / gsz; return true;
    }
    __device__ __forceinline__ void a_ready(const Unit&) const {}
    __device__ __forceinline__ void done(const Unit&) const {}
};

__device__ __forceinline__ unsigned cvt_pk_bf16(float lo, float hi) { unsigned r; asm volatile("v_cvt_pk_bf16_f32 %0, %1, %2" : "=v"(r) : "v"(lo), "v"(hi)); return r; }
typedef float f32x2 __attribute__((ext_vector_type(2)));
__device__ __forceinline__ f32x2 gelu_pk(f32x2 v) {
    const f32x2 av = __builtin_elementwise_abs(v), d = av * 0.2316418882f + 1.0f;
    f32x2 t; t.x = __builtin_amdgcn_rcpf(d.x); t.y = __builtin_amdgcn_rcpf(d.y);
    f32x2 q = t * 0.5307027145f + (-0.7265760135f); q = q * t + 0.7107068705f; q = q * t + (-0.142248368f); q = q * t + 0.127414796f; q = q * t;
    const f32x2 s = (v * v) * (-0.72134752044f);
    f32x2 e; e.x = __builtin_amdgcn_exp2f(s.x); e.y = __builtin_amdgcn_exp2f(s.y);
    const f32x2 m = v * (q * e), r = v - m;
    f32x2 o; o.x = v.x < 0.f ? m.x : r.x; o.y = v.y < 0.f ? m.y : r.y; return o;
}
template <class Epi, class Sched, bool ALIGN_EPI = false, bool SP2 = false>
__device__ __forceinline__ void gemm_phase(PG8_LAS unsigned char* lds, const Gemm g, const Sched& S, const Epi& E) {
    int tid_opaque = threadIdx.x; asm volatile("" : "+v"(tid_opaque));
    const int tid = tid_opaque, wid = __builtin_amdgcn_readfirstlane(tid >> 6), lane = tid & 63, wr = wid >> 2, wc = wid & 3, fr = lane & 15, fq = lane >> 4;
    const int K = g.K, nt = K / BK;
    unsigned voffA[2], voffB[2];
#pragma unroll
    for (int i = 0; i < 2; ++i) { int R, C; stage_rc(tid * 16 + i * 8192, R, C); const int Rb = Epi::PERM ? ((R & ~31) + perm32(R & 31)) : R;
        voffA[i] = (unsigned)(R * K + C) * 2u; voffB[i] = (unsigned)(Rb * K + C) * 2u; }
    const size_t kstep = (size_t)(BK * 2);
    const size_t hstep = (size_t)HALF * K * 2;
    const size_t tstep = 2 * hstep;
    const unsigned ldsw = (unsigned)wid * 1024u;
    const int aoff = lds_byte(wr * 64 + fr, fq * 8), boff = lds_byte(wc * 32 + fr, fq * 8);
#define PG8_SA(b, h) (((b) * 2 + (h)) * HTB)
#define PG8_SB(b, h) ((4 + (b) * 2 + (h)) * HTB)
#define PG8_STAGE(bufoff, gbase, voff) do { _Pragma("unroll") for (int _i = 0; _i < 2; ++_i) \
        __builtin_amdgcn_global_load_lds((const unsigned*)((const char*)(gbase) + (voff)[_i]), (PG8_LAS unsigned*)(lds + (bufoff) + ldsw + _i * 8192), 16, 0, 0); } while (0)
#define PG8_LDA(dst, b, h) do { _Pragma("unroll") for (int m = 0; m < 4; ++m) _Pragma("unroll") for (int k = 0; k < 2; ++k) dst[m][k] = *(const PG8_LAS bf16x8*)(lds + PG8_SA(b, h) + aoff + m * 2048 + k * 1024); } while (0)
#define PG8_LDB(dst, b, h) do { _Pragma("unroll") for (int n = 0; n < 2; ++n) _Pragma("unroll") for (int k = 0; k < 2; ++k) dst[n][k] = *(const PG8_LAS bf16x8*)(lds + PG8_SB(b, h) + boff + n * 2048 + k * 1024); } while (0)
#define PG8_MMA(ai, bj, At, Bt) do { __builtin_amdgcn_s_setprio(1); _Pragma("unroll") for (int m = 0; m < 4; ++m) _Pragma("unroll") for (int n = 0; n < 2; ++n) _Pragma("unroll") for (int k = 0; k < 2; ++k) \
        acc[ai][bj][m][n] = __builtin_amdgcn_mfma_f32_16x16x32_bf16(Bt[n][k], At[m][k], acc[ai][bj][m][n], 0, 0, 0); __builtin_amdgcn_s_setprio(0); } while (0)
#define PG8_WAIT_V(n) asm volatile("s_waitcnt vmcnt(" #n ")" ::: "memory")
#define PG8_WAIT_L(n) asm volatile("s_waitcnt lgkmcnt(" #n ")" ::: "memory")
#define PG8_BAR __builtin_amdgcn_s_barrier()
#define PG8_SCHED __builtin_amdgcn_sched_barrier(0)
    Unit cur, nxt; int ui = 0;
    if (!S.next(0, cur)) return;
    f32x4 acc[2][2][4][2];
#pragma unroll
    for (int a = 0; a < 2; ++a)
#pragma unroll
        for (int b = 0; b < 2; ++b)
#pragma unroll
            for (int m = 0; m < 4; ++m)
#pragma unroll
                for (int n = 0; n < 2; ++n) acc[a][b][m][n] = (f32x4){0.f, 0.f, 0.f, 0.f};
    bf16x8 At[4][2], B0[2][2], B1[2][2];
    const char* cA = (const char*)g.A + (size_t)cur.pm * tstep; const char* cB = (const char*)g.Bt + (size_t)cur.pn * tstep;
    S.a_ready(cur);
    if constexpr (SP2) {
        PG8_STAGE(PG8_SB(0, 0), cB, voffB); PG8_STAGE(PG8_SB(0, 1), cB + hstep, voffB); PG8_STAGE(PG8_SA(0, 0), cA, voffA); PG8_STAGE(PG8_SA(0, 1), cA + hstep, voffA);
        if (wr == 1) PG8_BAR;
        PG8_WAIT_V(2); PG8_BAR;
        PG8_STAGE(PG8_SB(1, 0), cB + kstep, voffB); PG8_STAGE(PG8_SA(1, 0), cA + kstep, voffA); PG8_STAGE(PG8_SB(1, 1), cB + hstep + kstep, voffB);
        PG8_WAIT_V(6); PG8_BAR;
    } else {
        PG8_STAGE(PG8_SB(0, 0), cB, voffB); PG8_STAGE(PG8_SA(0, 0), cA, voffA); PG8_STAGE(PG8_SB(0, 1), cB + hstep, voffB); PG8_STAGE(PG8_SA(0, 1), cA + hstep, voffA);
        if (wr == 1) PG8_BAR;
        PG8_WAIT_V(4); PG8_BAR;
        PG8_STAGE(PG8_SB(1, 0), cB + kstep, voffB); PG8_STAGE(PG8_SA(1, 0), cA + kstep, voffA); PG8_STAGE(PG8_SB(1, 1), cB + hstep + kstep, voffB);
        PG8_WAIT_V(6); PG8_BAR;
    }
    for (;;) {
        const bool has_next = S.next(ui + 1, nxt);
        const char* nA = has_next ? (const char*)g.A + (size_t)nxt.pm * tstep : cA; const char* nB = has_next ? (const char*)g.Bt + (size_t)nxt.pn * tstep : cB;
        for (int t = 0; t < nt; t += 2) {
            const bool last = (t == nt - 2);
            const char* a1 = cA + (size_t)(t + 1) * kstep;
            const char* a2 = last ? nA : cA + (size_t)(t + 2) * kstep; const char* b2 = last ? nB : cB + (size_t)(t + 2) * kstep;
            const char* a3 = a2 + kstep; const char* b3 = b2 + kstep;
            if (last && has_next) S.a_ready(nxt);
            if constexpr (SP2) {
            PG8_LDB(B0, 0, 0); PG8_LDB(B1, 0, 1); PG8_SCHED; PG8_LDA(At, 0, 0); PG8_STAGE(PG8_SA(1, 1), a1 + hstep, voffA);
            PG8_WAIT_V(8); PG8_WAIT_L(0); PG8_BAR; PG8_MMA(0, 0, At, B0); PG8_MMA(0, 1, At, B1); PG8_BAR; PG8_SCHED;
            PG8_LDA(At, 0, 1); PG8_STAGE(PG8_SB(0, 0), b2, voffB); PG8_STAGE(PG8_SB(0, 1), b2 + hstep, voffB); PG8_STAGE(PG8_SA(0, 0), a2, voffA);
            PG8_WAIT_V(8); PG8_WAIT_L(0); PG8_BAR; PG8_MMA(1, 0, At, B0); PG8_MMA(1, 1, At, B1); PG8_BAR; PG8_SCHED;
            PG8_LDB(B0, 1, 0); PG8_LDB(B1, 1, 1); PG8_SCHED; PG8_LDA(At, 1, 0); PG8_STAGE(PG8_SA(0, 1), a2 + hstep, voffA);
            PG8_WAIT_V(8); PG8_WAIT_L(0); PG8_BAR; PG8_MMA(0, 0, At, B0); PG8_MMA(0, 1, At, B1); PG8_BAR; PG8_SCHED;
            PG8_LDA(At, 1, 1); PG8_STAGE(PG8_SB(1, 0), b3, voffB); PG8_STAGE(PG8_SB(1, 1), b3 + hstep, voffB); PG8_STAGE(PG8_SA(1, 0), a3, voffA);
            PG8_WAIT_V(8); PG8_WAIT_L(0); PG8_BAR; PG8_MMA(1, 0, At, B0); PG8_MMA(1, 1, At, B1); PG8_BAR; PG8_SCHED;
            } else {
            PG8_LDB(B0, 0, 0); PG8_SCHED; PG8_LDA(At, 0, 0); PG8_STAGE(PG8_SA(1, 1), a1 + hstep, voffA);
            PG8_WAIT_L(8); PG8_BAR; PG8_WAIT_L(0); PG8_MMA(0, 0, At, B0); PG8_BAR; PG8_SCHED;
            PG8_LDB(B1, 0, 1); PG8_STAGE(PG8_SB(0, 0), b2, voffB);
            PG8_BAR; PG8_WAIT_L(0); PG8_MMA(0, 1, At, B1); PG8_BAR;
            PG8_LDA(At, 0, 1); PG8_STAGE(PG8_SA(0, 0), a2, voffA);
            PG8_BAR; PG8_WAIT_L(0); PG8_MMA(1, 0, At, B0); PG8_BAR; PG8_SCHED;
            PG8_STAGE(PG8_SB(0, 1), b2 + hstep, voffB);
            PG8_WAIT_V(6); PG8_BAR; PG8_MMA(1, 1, At, B1); PG8_BAR;
            PG8_LDB(B0, 1, 0); PG8_SCHED; PG8_LDA(At, 1, 0); PG8_STAGE(PG8_SA(0, 1), a2 + hstep, voffA);
            PG8_WAIT_L(8); PG8_BAR; PG8_WAIT_L(0); PG8_MMA(0, 0, At, B0); PG8_BAR; PG8_SCHED;
            PG8_LDB(B1, 1, 1); PG8_STAGE(PG8_SB(1, 0), b3, voffB);
            PG8_BAR; PG8_WAIT_L(0); PG8_MMA(0, 1, At, B1); PG8_BAR;
            PG8_LDA(At, 1, 1); PG8_STAGE(PG8_SA(1, 0), a3, voffA);
            PG8_BAR; PG8_WAIT_L(0); PG8_MMA(1, 0, At, B0); PG8_BAR; PG8_SCHED;
            PG8_STAGE(PG8_SB(1, 1), b3 + hstep, voffB);
            PG8_WAIT_V(6); PG8_BAR; PG8_MMA(1, 1, At, B1); PG8_BAR;
            }
        }
        if constexpr (ALIGN_EPI) { if (wr == 0) PG8_BAR; }
        if constexpr (!Epi::AFTER_DRAIN) { E(acc, cur, wr, wc, fr, fq); S.done(cur); }
        if (!has_next) break;
        if (!(Epi::CHAIN && E.keep(cur))) {
#pragma unroll
        for (int a = 0; a < 2; ++a)
#pragma unroll
            for (int b = 0; b < 2; ++b)
#pragma unroll
                for (int m = 0; m < 4; ++m)
#pragma unroll
                    for (int n = 0; n < 2; ++n) acc[a][b][m][n] = (f32x4){0.f, 0.f, 0.f, 0.f};
        }
        cur = nxt; cA = nA; cB = nB; ++ui;
        if constexpr (ALIGN_EPI) { if (wr == 1) PG8_BAR; }
    }
    PG8_WAIT_V(0);
    if constexpr (!ALIGN_EPI) { if (wr == 0) PG8_BAR; }
    PG8_BAR;
    if constexpr (Epi::AFTER_DRAIN) { E.fused(acc, cur, wr, wc, fr, fq, lds, wid, lane); S.done(cur); }
#undef PG8_SA
#undef PG8_SB
#undef PG8_STAGE
#undef PG8_LDA
#undef PG8_LDB
#undef PG8_MMA
#undef PG8_WAIT_V
#undef PG8_WAIT_L
#undef PG8_BAR
#undef PG8_SCHED
}
}

#ifndef REP_MASK
#define REP_MASK 0
#endif
#ifndef PROBE_T
#define PROBE_T 0
#endif
#ifndef PROBE_P
#define PROBE_P 0
#endif
#ifndef PROBE_S
#define PROBE_S 0
#endif
#ifndef PROBE_D
#define PROBE_D 0
#endif
#ifndef PROBE_Y
#define PROBE_Y 0
#endif
#ifndef REP_SYNC
#define REP_SYNC 0
#endif
#ifndef REP_MIX
#define REP_MIX 0
#endif
#ifndef MIX_ON
#define MIX_ON 7
#endif
#ifndef PH_ON
#define PH_ON 1023
#endif
#ifndef N_LAUNCH_MODE
#define N_LAUNCH_MODE 1
#endif
#define LAS __attribute__((address_space(3)))
typedef unsigned short bf16;
typedef unsigned v4u __attribute__((ext_vector_type(4)));
typedef unsigned v2u __attribute__((ext_vector_type(2)));
typedef int v4i __attribute__((ext_vector_type(4)));
typedef float f32x4 __attribute__((ext_vector_type(4)));
typedef float f32x2 __attribute__((ext_vector_type(2)));

constexpr int NTHR = 512;
constexpr int M = 8192, D = 2048, DEPTH = 2, INC = 10752;
constexpr int C_Q = 1024, C_K = 2048, C_V = 2304, C_SGU = 2560, C_GATE = 4608;
constexpr float EPS = 1e-6f;
constexpr int LDS_BYTES = 147456;
constexpr int NPHASE = 1 + 8 * DEPTH;
constexpr size_t MiB = 1u << 20;
constexpr size_t WS_ABAR = 1 * MiB, WS_BBAR = 2 * MiB, WS_SCL = 3 * MiB, WS_SEND = 4 * MiB, WS_WIN = 8 * MiB, WS_WGLU = 92 * MiB, WS_WBR = 96 * MiB, WS_WOUT = 120 * MiB,
                 WS_WQK = 136 * MiB, WS_PU = 152 * MiB, WS_PV = 280 * MiB, WS_H = 408 * MiB, WS_XN = 440 * MiB, WS_PROJ = 472 * MiB, WS_YG = 640 * MiB,
                 WS_YS = 656 * MiB, WS_MTMP = 704 * MiB, WS_MERGED = 768 * MiB, WS_SCORES = 800 * MiB, WS_END = 864 * MiB;

#define LDS_WAIT() asm volatile("s_waitcnt lgkmcnt(0)" ::: "memory")
__device__ __forceinline__ unsigned pk2(float lo, float hi) { return pg8::cvt_pk_bf16(lo, hi); }
__device__ __forceinline__ float bflo(unsigned w) { return __uint_as_float(w << 16); }
__device__ __forceinline__ float bfhi(unsigned w) { return __uint_as_float(w & 0xffff0000u); }
__device__ __forceinline__ void unpack8(const v4u w, float* f) { f[0] = bflo(w.x); f[1] = bfhi(w.x); f[2] = bflo(w.y); f[3] = bfhi(w.y); f[4] = bflo(w.z); f[5] = bfhi(w.z); f[6] = bflo(w.w); f[7] = bfhi(w.w); }
__device__ __forceinline__ v4u pack8(const float* f) { v4u o; o.x = pk2(f[0], f[1]); o.y = pk2(f[2], f[3]); o.z = pk2(f[4], f[5]); o.w = pk2(f[6], f[7]); return o; }
__device__ __forceinline__ float wave_sum(float v) {
#pragma unroll
    for (int o = 1; o < 64; o <<= 1) v += __shfl_xor(v, o);
    return v;
}
__device__ __forceinline__ float gelu_s(float v) {
    const float av = fabsf(v), d = av * 0.2316418882f + 1.0f; const float t = __builtin_amdgcn_rcpf(d);
    float q = t * 0.5307027145f + (-0.7265760135f); q = q * t + 0.7107068705f; q = q * t + (-0.142248368f); q = q * t + 0.127414796f; q = q * t;
    const float e = __builtin_amdgcn_exp2f(v * v * (-0.72134752044f));
    const float m = v * (q * e); return v < 0.f ? m : v - m;
}
__device__ __forceinline__ float sigmoid_s(float v) { return __builtin_amdgcn_rcpf(1.0f + __builtin_amdgcn_exp2f(-1.4426950408889634f * v)); }

__device__ __forceinline__ float ld_acc(const float* p) { return __hip_atomic_load(p, __ATOMIC_RELAXED, __HIP_MEMORY_SCOPE_AGENT); }
struct EpiProj {
    static constexpr bool PERM = true, AFTER_DRAIN = false, CHAIN = false; __device__ __forceinline__ bool keep(const pg8::Unit&) const { return false; } bf16* O; float* sgst;
    __device__ __forceinline__ void operator()(const pg8::f32x4 (&acc)[2][2][4][2], const pg8::Unit& u, int wr, int wc, int fr, int fq) const {
        const int row0 = u.pm * 256 + wr * 64 + fr, col0 = u.pn * 256 + wc * 32 + 8 * fq;
        const int act = u.pn < 10 ? 0 : (u.pn < 18 ? 1 : 2);
        const bool stats = (u.pn >= 14 && u.pn < 18);
#pragma unroll
        for (int ai = 0; ai < 2; ++ai)
#pragma unroll
            for (int m = 0; m < 4; ++m) { bf16* rowp = O + (size_t)(row0 + ai * 128 + m * 16) * INC + col0; float s1 = 0.f, s2 = 0.f;
#pragma unroll
                for (int bj = 0; bj < 2; ++bj) { float v[8];
#pragma unroll
                    for (int e = 0; e < 4; ++e) { v[e] = acc[ai][bj][m][0][e]; v[4 + e] = acc[ai][bj][m][1][e]; }
                    if (act == 1) {
#pragma unroll
                        for (int e = 0; e < 8; ++e) v[e] = gelu_s(v[e]);
                    } else if (act == 2) {
#pragma unroll
                        for (int e = 0; e < 8; ++e) v[e] = sigmoid_s(v[e]);
                    }
                    const v4u pk = pack8(v); *(v4u*)(rowp + bj * 128) = pk;
                    if (stats) { float r8[8]; unpack8(pk, r8);
#pragma unroll
                        for (int e = 0; e < 8; ++e) { s1 += r8[e]; s2 += r8[e] * r8[e]; } } }
                if (stats) { s1 += __shfl_xor(s1, 16); s1 += __shfl_xor(s1, 32); s2 += __shfl_xor(s2, 16); s2 += __shfl_xor(s2, 32);
                    if (fq == 0) *(f32x2*)(sgst + (size_t)(row0 + ai * 128 + m * 16) * 32 + (u.pn - 14) * 8 + wc * 2) = (f32x2){s1, s2}; } }
    }
};
struct EpiGlu {
    static constexpr bool PERM = true, AFTER_DRAIN = false, CHAIN = false; __device__ __forceinline__ bool keep(const pg8::Unit&) const { return false; } const bf16* YG; const float* bias; bf16* O;
    __device__ __forceinline__ void operator()(const pg8::f32x4 (&acc)[2][2][4][2], const pg8::Unit& u, int wr, int wc, int fr, int fq) const {
        const int row0 = u.pm * 256 + wr * 64 + fr, col0 = u.pn * 256 + wc * 32 + 8 * fq;
#pragma unroll
        for (int bj = 0; bj < 2; ++bj) { const f32x4 b0 = *(const f32x4*)(bias + col0 + bj * 128), b1 = *(const f32x4*)(bias + col0 + bj * 128 + 4);
#pragma unroll
            for (int ai = 0; ai < 2; ++ai)
#pragma unroll
                for (int m = 0; m < 4; ++m) { const size_t off = (size_t)(row0 + ai * 128 + m * 16) * 1024 + col0 + bj * 128;
                    float y[8]; unpack8(*(const v4u*)(YG + off), y); float v[8];
#pragma unroll
                    for (int e = 0; e < 4; ++e) { v[e] = y[e] * sigmoid_s(acc[ai][bj][m][0][e] + b0[e]); v[4 + e] = y[4 + e] * sigmoid_s(acc[ai][bj][m][1][e] + b1[e]); }
                    *(v4u*)(O + off) = pack8(v); } }
    }
};
struct EpiBranch {
    static constexpr bool PERM = true, AFTER_DRAIN = false, CHAIN = true; const bf16* proj; bf16* merged;
    __device__ __forceinline__ bool keep(const pg8::Unit& u) const { return (u.pm >> 5) < 2; }
    __device__ __forceinline__ void operator()(pg8::f32x4 (&acc)[2][2][4][2], const pg8::Unit& u, int wr, int wc, int fr, int fq) const {
        const int n = u.pm >> 5, pm = u.pm & 31, pn = u.pn & 7;
        const int row0 = pm * 256 + wr * 64 + fr, col0 = pn * 256 + wc * 32 + 8 * fq;
#pragma unroll
        for (int ai = 0; ai < 2; ++ai)
#pragma unroll
            for (int m = 0; m < 4; ++m) { const int row = row0 + ai * 128 + m * 16;
#pragma unroll
                for (int bj = 0; bj < 2; ++bj) { const int col = col0 + bj * 128; const bf16* gp = proj + (size_t)row * INC + C_GATE + n * 2048 + col;
                    float g[8]; unpack8(*(const v4u*)gp, g);
                    if (n < 2) { float gn[8]; unpack8(*(const v4u*)(gp + 2048), gn);
#pragma unroll
                        for (int e = 0; e < 8; ++e) g[e] = fmaxf(g[e], 1e-30f) * __builtin_amdgcn_rcpf(fmaxf(gn[e], 1e-30f));
#pragma unroll
                        for (int e = 0; e < 4; ++e) { acc[ai][bj][m][0][e] *= g[e]; acc[ai][bj][m][1][e] *= g[4 + e]; }
                    } else { float v[8];
#pragma unroll
                        for (int e = 0; e < 4; ++e) { v[e] = fmaxf(g[e], 1e-30f) * acc[ai][bj][m][0][e]; v[4 + e] = fmaxf(g[4 + e], 1e-30f) * acc[ai][bj][m][1][e]; }
                        *(v4u*)(merged + (size_t)row * 2048 + col) = pack8(v); } } }
    }
};
struct RangeOrder {
    pg8::StaticOrder base; int lo, hi, G2, c2;
    __device__ __forceinline__ bool next(int i, pg8::Unit& u) const { const int L = lo + i * G2 + c2; if (L >= hi) return false; pg8::StaticOrder t = base; t.c = L % base.G; return t.next(L / base.G, u); }
    __device__ __forceinline__ void a_ready(const pg8::Unit&) const {}
    __device__ __forceinline__ void done(const pg8::Unit&) const {}
};
struct BranchOrder {
    int G, c;
    __device__ __forceinline__ bool next(int i, pg8::Unit& u) const { const int L = (i / 3) * G + c; if (L >= 256) return false; const int n = i % 3; u.pm = n * 32 + (L >> 3); u.pn = n * 8 + (L & 7); return true; }
    __device__ __forceinline__ void a_ready(const pg8::Unit&) const {}
    __device__ __forceinline__ void done(const pg8::Unit&) const {}
};
struct EpiResid {
    static constexpr bool PERM = false, AFTER_DRAIN = false, CHAIN = false; __device__ __forceinline__ bool keep(const pg8::Unit&) const { return false; } const float* base; float* out;
    __device__ __forceinline__ void operator()(const pg8::f32x4 (&acc)[2][2][4][2], const pg8::Unit& u, int wr, int wc, int fr, int fq) const {
        const int row0 = u.pm * 256 + wr * 64 + fr, col0 = u.pn * 256 + wc * 32 + 4 * fq;
#pragma unroll
        for (int ai = 0; ai < 2; ++ai)
#pragma unroll
            for (int m = 0; m < 4; ++m) { const size_t off = (size_t)(row0 + ai * 128 + m * 16) * 2048 + col0;
#pragma unroll
                for (int bj = 0; bj < 2; ++bj)
#pragma unroll
                    for (int n = 0; n < 2; ++n) { const f32x4 b = *(const f32x4*)(base + off + bj * 128 + n * 16); f32x4 o;
#pragma unroll
                        for (int e = 0; e < 4; ++e) o[e] = b[e] + acc[ai][bj][m][n][e];
                        *(f32x4*)(out + off + bj * 128 + n * 16) = o; } }
    }
};
struct EpiResidNorm {
    static constexpr bool PERM = false, AFTER_DRAIN = false, CHAIN = false; __device__ __forceinline__ bool keep(const pg8::Unit&) const { return false; } const float* base; float* out; const float* g2; bf16* xnb; float* rowss;
    __device__ __forceinline__ void operator()(const pg8::f32x4 (&acc)[2][2][4][2], const pg8::Unit& u, int wr, int wc, int fr, int fq) const {
        const int row0 = u.pm * 256 + wr * 64 + fr, col0 = u.pn * 256 + wc * 32 + 4 * fq;
#pragma unroll
        for (int ai = 0; ai < 2; ++ai)
#pragma unroll
            for (int m = 0; m < 4; ++m) { const int row = row0 + ai * 128 + m * 16; const size_t off = (size_t)row * 2048 + col0; float ss = 0.f;
#pragma unroll
                for (int bj = 0; bj < 2; ++bj)
#pragma unroll
                    for (int n = 0; n < 2; ++n) { const f32x4 b = *(const f32x4*)(base + off + bj * 128 + n * 16); const f32x4 g = *(const f32x4*)(g2 + col0 + bj * 128 + n * 16); f32x4 o;
#pragma unroll
                        for (int e = 0; e < 4; ++e) { o[e] = b[e] + acc[ai][bj][m][n][e]; ss += o[e] * o[e]; }
                        *(f32x4*)(out + off + bj * 128 + n * 16) = o;
                        v2u w; w.x = pk2(o[0] * g[0], o[1] * g[1]); w.y = pk2(o[2] * g[2], o[3] * g[3]); *(v2u*)(xnb + off + bj * 128 + n * 16) = w; }
                ss += __shfl_xor(ss, 16); ss += __shfl_xor(ss, 32);
                if (fq == 0) rowss[(size_t)row * 32 + u.pn * 4 + wc] = ss; }
    }
};
struct EpiScoreF32 {
    static constexpr bool PERM = false, AFTER_DRAIN = false, CHAIN = false; __device__ __forceinline__ bool keep(const pg8::Unit&) const { return false; } float* out; const float* rowss;
    __device__ __forceinline__ void operator()(const pg8::f32x4 (&acc)[2][2][4][2], const pg8::Unit& u, int wr, int wc, int fr, int fq) const {
        const int row0 = u.pm * 256 + wr * 64 + fr, col0 = u.pn * 256 + wc * 32 + 4 * fq;
#pragma unroll
        for (int ai = 0; ai < 2; ++ai)
#pragma unroll
            for (int m = 0; m < 4; ++m) { const int row = row0 + ai * 128 + m * 16; const size_t off = (size_t)row * 2048 + col0; const f32x4* pp = (const f32x4*)(rowss + (size_t)row * 32) + fq * 2; const f32x4 p0 = pp[0], p1 = pp[1]; float sq = ((p0.x + p0.y) + (p0.z + p0.w)) + ((p1.x + p1.y) + (p1.z + p1.w)); sq += __shfl_xor(sq, 16); sq += __shfl_xor(sq, 32);
                const float rstd = rsqrtf(sq * (1.f / 2048.f) + EPS);
#pragma unroll
                for (int bj = 0; bj < 2; ++bj)
#pragma unroll
                    for (int n = 0; n < 2; ++n) { f32x4 o;
#pragma unroll
                        for (int e = 0; e < 4; ++e) o[e] = acc[ai][bj][m][n][e] * rstd;
                        *(f32x4*)(out + off + bj * 128 + n * 16) = o; } }
    }
};
struct EpiF32 {
    static constexpr bool PERM = false, AFTER_DRAIN = false, CHAIN = false; __device__ __forceinline__ bool keep(const pg8::Unit&) const { return false; } float* out;
    __device__ __forceinline__ void operator()(const pg8::f32x4 (&acc)[2][2][4][2], const pg8::Unit& u, int wr, int wc, int fr, int fq) const {
        const int row0 = u.pm * 256 + wr * 64 + fr, col0 = u.pn * 256 + wc * 32 + 4 * fq;
#pragma unroll
        for (int ai = 0; ai < 2; ++ai)
#pragma unroll
            for (int m = 0; m < 4; ++m) { const size_t off = (size_t)(row0 + ai * 128 + m * 16) * 2048 + col0;
#pragma unroll
                for (int bj = 0; bj < 2; ++bj)
#pragma unroll
                    for (int n = 0; n < 2; ++n) { f32x4 o;
#pragma unroll
                        for (int e = 0; e < 4; ++e) o[e] = acc[ai][bj][m][n][e];
                        *(f32x4*)(out + off + bj * 128 + n * 16) = o; } }
    }
};

__device__ __forceinline__ void p0_transpose_item(const float* __restrict__ W, int K, int N, bf16* WT, LAS float* scr, int item, int lane) {
    const int nblk = N / 32, kb = item / nblk, nb = item % nblk, k0 = 64 * kb, n0 = 32 * nb;
    float wv[32];
#pragma unroll
    for (int i = 0; i < 32; ++i) wv[i] = W[(size_t)(k0 + 2 * i + (lane >> 5)) * N + n0 + (lane & 31)];
#pragma unroll
    for (int i = 0; i < 32; ++i) scr[(2 * i + (lane >> 5)) * 33 + (lane & 31)] = wv[i];
    LDS_WAIT();
    const int c = lane & 7;
#pragma unroll
    for (int j = 0; j < 4; ++j) { const int n = (lane >> 3) + 8 * j; const LAS float* s = scr + (8 * c) * 33 + n;
        v4u o; o.x = pk2(s[0 * 33], s[1 * 33]); o.y = pk2(s[2 * 33], s[3 * 33]); o.z = pk2(s[4 * 33], s[5 * 33]); o.w = pk2(s[6 * 33], s[7 * 33]);
        *(v4u*)(WT + (size_t)(n0 + n) * K + k0 + 8 * c) = o; }
    LDS_WAIT();
}
__device__ __forceinline__ void rms_row_to_bf16(const float* xrow, const float* g, bf16* orow, int lane) {
    const f32x4* xr = (const f32x4*)xrow + lane; const f32x4* gr = (const f32x4*)g + lane;
    f32x4 v[8]; float s = 0.f;
#pragma unroll
    for (int j = 0; j < 8; ++j) { v[j] = xr[64 * j]; s += (v[j].x * v[j].x + v[j].y * v[j].y) + (v[j].z * v[j].z + v[j].w * v[j].w); }
    const float rstd = rsqrtf(wave_sum(s) * (1.f / 2048.f) + EPS);
    v2u* o8 = (v2u*)orow + lane;
#pragma unroll
    for (int j = 0; j < 8; ++j) { const f32x4 gg = gr[64 * j]; v2u o; o.x = pk2(v[j].x * rstd * gg.x, v[j].y * rstd * gg.y); o.y = pk2(v[j].z * rstd * gg.z, v[j].w * rstd * gg.w); o8[64 * j] = o; }
}

typedef short s16x4 __attribute__((ext_vector_type(4)));
template <bool PASS_C>
__device__ __forceinline__ void ssm_item(int item, int l, const bf16* proj, const float* abar, const bf16* bbt, const float* cre, const float* cim, const float* dvec,
                                         float* send, bf16* yg, LAS unsigned char* lds, int tid, int lane, int wave, int nblk = 16) {
    const int b = item >> 7, g = (item >> 1) & 63, c = (item & 1) * 8 + wave;
    const int tok0 = b * 4096 + c * 256;
    LAS unsigned char* UL = lds + wave * 16640; LAS float* BL = (LAS float*)(lds + wave * 16640 + 8192); LAS float* SL = BL;
    const int c16 = lane & 15, quad = lane >> 4;
    { v4u uw[8];
#pragma unroll
      for (int i = 0; i < 4; ++i) { const v4u* up = (const v4u*)(proj + (size_t)(tok0 + i * 64 + lane) * INC + g * 16); uw[2 * i] = up[0]; uw[2 * i + 1] = up[1]; }
#pragma unroll
      for (int i = 0; i < 4; ++i) { *(LAS v4u*)(UL + (i * 64 + lane) * 32) = uw[2 * i]; *(LAS v4u*)(UL + (i * 64 + lane) * 32 + 16) = uw[2 * i + 1]; } }
    const f32x2 a = *(const f32x2*)(abar + (size_t)((l * 64 + g) * 64 + lane) * 2);
    float sr = 0.f, si = 0.f;
    if (PASS_C) {
        float tr = a.x, ti = a.y;
#pragma unroll
        for (int k = 0; k < 8; ++k) { const float nr = tr * tr - ti * ti; ti = 2.f * tr * ti; tr = nr; }
        const float* sp = send + ((size_t)b * 1024 + g) * 128 + lane * 2;
        float pr = 1.f, pi = 0.f;
        f32x2 e[16];
#pragma unroll
        for (int k = 0; k < 16; ++k) { const int cp = c - 1 - k; e[k] = *(const f32x2*)(sp + (size_t)(cp < 0 ? 0 : cp) * 8192); if (cp < 0) e[k] = (f32x2){0.f, 0.f}; }
#pragma unroll
        for (int k = 0; k < 16; ++k) { sr += pr * e[k].x - pi * e[k].y; si += pr * e[k].y + pi * e[k].x; const float npr = pr * tr - pi * ti; pi = pr * ti + pi * tr; pr = npr; }
    }
    v2u bw[8];
#pragma unroll
    for (int nt = 0; nt < 8; ++nt) bw[nt] = *(const v2u*)(bbt + ((size_t)((l * 64 + g) * 128 + nt * 16 + c16)) * 16 + quad * 4);
    v4u cA[4];
    if (PASS_C) {
        const float* cr = cre + (size_t)((l * 64 + g) * 16 + c16) * 64 + quad * 4; const float* ci = cim + (size_t)((l * 64 + g) * 16 + c16) * 64 + quad * 4;
#pragma unroll
        for (int ks = 0; ks < 4; ++ks) { const f32x4 re = *(const f32x4*)(cr + ks * 16), im = *(const f32x4*)(ci + ks * 16);
            cA[ks] = (v4u){pk2(re.x, -im.x), pk2(re.y, -im.y), pk2(re.z, -im.z), pk2(re.w, -im.w)}; }
    }
    f32x4 dd = (f32x4){0.f, 0.f, 0.f, 0.f};
    if (PASS_C) dd = *(const f32x4*)(dvec + l * 1024 + g * 16 + quad * 4);
#pragma unroll 1
    for (int blk = 0; blk < nblk; ++blk) {
        const v2u ua = *(const LAS v2u*)(UL + (blk * 16 + c16) * 32 + quad * 8);
        const s16x4 ua4 = __builtin_bit_cast(s16x4, ua);
#if PROBE_D
#pragma unroll 1
        for (int rpd = 0; rpd < 3; ++rpd)
#endif
#pragma unroll
        for (int nt = 0; nt < 8; ++nt) { const pg8::f32x4 d = __builtin_amdgcn_mfma_f32_16x16x16bf16_1k(ua4, __builtin_bit_cast(s16x4, bw[nt]), (pg8::f32x4){0.f, 0.f, 0.f, 0.f}, 0, 0, 0);
#pragma unroll
            for (int j = 0; j < 4; ++j) BL[(quad * 4 + j) * 132 + nt * 16 + c16] = d[j]; }
        LDS_WAIT();
#if PROBE_S
        const float sr0 = sr, si0 = si;
#pragma unroll 1
        for (int rps = 0; rps < 3; ++rps) { sr = sr0; si = si0; asm volatile("" : "+v"(sr), "+v"(si));
            if (rps > 0) {
#pragma unroll
                for (int nt = 0; nt < 8; ++nt) { const pg8::f32x4 d = __builtin_amdgcn_mfma_f32_16x16x16bf16_1k(ua4, __builtin_bit_cast(s16x4, bw[nt]), (pg8::f32x4){0.f, 0.f, 0.f, 0.f}, 0, 0, 0);
#pragma unroll
                    for (int j = 0; j < 4; ++j) BL[(quad * 4 + j) * 132 + nt * 16 + c16] = d[j]; }
                LDS_WAIT(); }
#endif
        f32x2 bu[16];
#pragma unroll
        for (int t = 0; t < 16; ++t) bu[t] = *(const LAS f32x2*)(BL + t * 132 + 2 * lane);
        LDS_WAIT();
#pragma unroll
        for (int t = 0; t < 16; ++t) {
            const float nr = a.x * sr - a.y * si + bu[t].x; si = a.x * si + a.y * sr + bu[t].y; sr = nr;
            if (PASS_C) *(LAS f32x2*)(SL + t * 132 + 2 * lane) = (f32x2){sr, si}; }
#if PROBE_S
        LDS_WAIT(); }
#endif
        if (PASS_C) {
            LDS_WAIT();
            pg8::f32x4 yacc = (pg8::f32x4){0.f, 0.f, 0.f, 0.f};
#if PROBE_Y
#pragma unroll 1
            for (int rpy = 0; rpy < 3; ++rpy) { yacc = (pg8::f32x4){0.f, 0.f, 0.f, 0.f}; asm volatile("" : "+v"(yacc));
#endif
            f32x4 sv[8];
#pragma unroll
            for (int ks = 0; ks < 4; ++ks) { sv[2 * ks] = *(const LAS f32x4*)(SL + c16 * 132 + ks * 32 + quad * 8); sv[2 * ks + 1] = *(const LAS f32x4*)(SL + c16 * 132 + ks * 32 + quad * 8 + 4); }
            LDS_WAIT();
#pragma unroll
            for (int ks = 0; ks < 4; ++ks) { const v4u sb = (v4u){pk2(sv[2 * ks].x, sv[2 * ks].y), pk2(sv[2 * ks].z, sv[2 * ks].w), pk2(sv[2 * ks + 1].x, sv[2 * ks + 1].y), pk2(sv[2 * ks + 1].z, sv[2 * ks + 1].w)};
                yacc = __builtin_amdgcn_mfma_f32_16x16x32_bf16(__builtin_bit_cast(pg8::bf16x8, cA[ks]), __builtin_bit_cast(pg8::bf16x8, sb), yacc, 0, 0, 0); }
#if PROBE_Y
            }
#endif
            const float y0 = gelu_s(yacc[0] + dd.x * bflo(ua.x)), y1 = gelu_s(yacc[1] + dd.y * bfhi(ua.x)), y2 = gelu_s(yacc[2] + dd.z * bflo(ua.y)), y3 = gelu_s(yacc[3] + dd.w * bfhi(ua.y));
            v2u o; o.x = pk2(y0, y1); o.y = pk2(y2, y3);
            *(v2u*)(yg + (size_t)(tok0 + blk * 16 + c16) * 1024 + g * 16 + quad * 4) = o;
        }
        LDS_WAIT();
    }
    if (!PASS_C) *(f32x2*)(send + ((size_t)((b * 16 + c) * 64 + g) * 64 + lane) * 2) = (f32x2){sr, si};
}

__device__ __forceinline__ void attn_item(int item, int l, const bf16* proj, const float* qg, const float* kg, const float* sinks, bf16* ys1, LAS unsigned char* lds, int tid) {
    const int b = item >> 7, n = (item >> 2) & 31, kvh = item & 3;
    LAS unsigned char* KLb = lds;
    LAS unsigned short* VtL = (LAS unsigned short*)(lds + 36864);
    const int tokb = b * 4096 + n * 128 - 128;
#pragma unroll
    for (int i = 0; i < 4; ++i) {
        const int idx = tid + i * 512, row = idx >> 3, ch = idx & 7;
        v4u kw = (v4u){0u, 0u, 0u, 0u}, vw = (v4u){0u, 0u, 0u, 0u};
        if (n > 0 || row >= 128) { const bf16* kp = proj + (size_t)(tokb + row) * INC + C_K + kvh * 64 + ch * 8; kw = *(const v4u*)kp; vw = *(const v4u*)(kp + (C_V - C_K)); }
        float kf[8]; unpack8(kw, kf);
        float ss = 0.f;
#pragma unroll
        for (int e = 0; e < 8; ++e) ss += kf[e] * kf[e];
        ss += __shfl_xor(ss, 1); ss += __shfl_xor(ss, 2); ss += __shfl_xor(ss, 4);
        const float r = rsqrtf(ss * (1.f / 64.f) + EPS);
        const f32x4 g0 = *(const f32x4*)(kg + ch * 8), g1 = *(const f32x4*)(kg + ch * 8 + 4);
        kf[0] *= r * g0.x; kf[1] *= r * g0.y; kf[2] *= r * g0.z; kf[3] *= r * g0.w; kf[4] *= r * g1.x; kf[5] *= r * g1.y; kf[6] *= r * g1.z; kf[7] *= r * g1.w;
        *(LAS v4u*)(KLb + row * 144 + ch * 16) = pack8(kf);
#pragma unroll
        for (int e = 0; e < 8; ++e) VtL[(ch * 8 + e) * 264 + row] = (unsigned short)((vw[e >> 1] >> (16 * (e & 1))) & 0xffffu);
    }
    float gkmax = 0.f;
#pragma unroll 8
    for (int d = 0; d < 64; ++d) gkmax = fmaxf(gkmax, fabsf(kg[d]));
    const float LOG2E = 1.4426950408889634f;
    __syncthreads();
    const int lane = tid & 63, w = tid >> 6, c16 = lane & 15, quad = lane >> 4;
    const int g = w >> 1, tq0 = (w & 1) * 64, qh = kvh * 4 + g;
    const float sink2 = sinks[qh] * LOG2E;
#pragma unroll 1
    for (int qt = 0; qt < 4; ++qt) {
        const int tmin = tq0 + qt * 16, t = tmin + c16, tok = b * 4096 + n * 128 + t;
        float qv[16];
        { const bf16* qp = proj + (size_t)tok * INC + C_Q + qh * 64; unpack8(*(const v4u*)(qp + quad * 8), qv); unpack8(*(const v4u*)(qp + 32 + quad * 8), qv + 8); }
        float ss = 0.f;
#pragma unroll
        for (int e = 0; e < 16; ++e) ss += qv[e] * qv[e];
        ss += __shfl_xor(ss, 16); ss += __shfl_xor(ss, 32);
        const float r = rsqrtf(ss * (1.f / 64.f) + EPS) * (0.125f * LOG2E);
        float qn2 = 0.f;
#pragma unroll
        for (int e = 0; e < 8; ++e) { qv[e] *= r * qg[quad * 8 + e]; qv[8 + e] *= r * qg[32 + quad * 8 + e]; qn2 += qv[e] * qv[e] + qv[8 + e] * qv[8 + e]; }
        qn2 += __shfl_xor(qn2, 16); qn2 += __shfl_xor(qn2, 32);
        const float Mb2 = fmaxf(sqrtf(qn2) * 8.f * gkmax, sink2);
        pg8::bf16x8 qB[2];
        qB[0] = __builtin_bit_cast(pg8::bf16x8, pack8(qv)); qB[1] = __builtin_bit_cast(pg8::bf16x8, pack8(qv + 8));
        pg8::f32x4 oacc[4];
#pragma unroll
        for (int dt = 0; dt < 4; ++dt) oacc[dt] = (pg8::f32x4){0.f, 0.f, 0.f, 0.f};
        float lsum = 0.f;
        int p_lo = (tmin + 1) >> 5; const int p_hi = (tmin + 143) >> 5;
        if (n == 0 && p_lo < 4) p_lo = 4;
#pragma unroll 1
        for (int p = p_lo; p <= p_hi; ++p) {
            pg8::f32x4 sacc[2];
#pragma unroll
            for (int tt = 0; tt < 2; ++tt) { sacc[tt] = (pg8::f32x4){0.f, 0.f, 0.f, 0.f};
#pragma unroll
                for (int ks = 0; ks < 2; ++ks) { const pg8::bf16x8 a = *(const LAS pg8::bf16x8*)(KLb + ((2 * p + tt) * 16 + c16) * 144 + ks * 64 + quad * 16);
                    sacc[tt] = __builtin_amdgcn_mfma_f32_16x16x32_bf16(a, qB[ks], sacc[tt], 0, 0, 0); } }
            float pe[8];
#pragma unroll
            for (int tt = 0; tt < 2; ++tt)
#pragma unroll
                for (int j = 0; j < 4; ++j) { const int kb = (2 * p + tt) * 16 + quad * 4 + j; const bool valid = (kb >= t + 1) && (kb <= t + 128) && (n > 0 || kb >= 128);
                    const float pv = valid ? __builtin_amdgcn_exp2f(sacc[tt][j] - Mb2) : 0.f; pe[tt * 4 + j] = pv; lsum += pv; }
            const pg8::bf16x8 pb = __builtin_bit_cast(pg8::bf16x8, pack8(pe));
#pragma unroll
            for (int dt = 0; dt < 4; ++dt) { const LAS unsigned short* vp = VtL + (dt * 16 + c16) * 264 + p * 32 + quad * 4;
                const v2u lo = *(const LAS v2u*)vp, hi = *(const LAS v2u*)(vp + 16);
                const pg8::bf16x8 a = __builtin_bit_cast(pg8::bf16x8, (v4u){lo.x, lo.y, hi.x, hi.y});
                oacc[dt] = __builtin_amdgcn_mfma_f32_16x16x32_bf16(a, pb, oacc[dt], 0, 0, 0); }
        }
        lsum += __shfl_xor(lsum, 16); lsum += __shfl_xor(lsum, 32);
        const float inv = 1.f / (lsum + __builtin_amdgcn_exp2f(sink2 - Mb2));
        bf16* op = ys1 + (size_t)tok * 1024 + qh * 64 + quad * 4;
#pragma unroll
        for (int dt = 0; dt < 4; ++dt) { v2u o; o.x = pk2(oacc[dt][0] * inv, oacc[dt][1] * inv); o.y = pk2(oacc[dt][2] * inv, oacc[dt][3] * inv); *(v2u*)(op + dt * 16) = o; }
    }
    __syncthreads();
}

__device__ __forceinline__ void sgu_item(int item, int l, const bf16* proj, const float* sgst, const float* lng, const float* lnb, const float* sw, const float* sb, bf16* ys2, LAS unsigned char* lds, int tid, int wave) {
    const int b = item >> 8, nc = (item >> 3) & 31, h = item & 7;
    const int tok0 = b * 4096 + nc * 128;
    LAS unsigned short* VnT = (LAS unsigned short*)lds;
    LAS unsigned short* Wb = (LAS unsigned short*)(lds + 34816);
    LAS float* ST = (LAS float*)(lds + 69632);
    if (tid < 128) { const f32x4* sp = (const f32x4*)(sgst + (size_t)(tok0 + tid) * 32); float s1 = 0.f, s2 = 0.f;
#pragma unroll
        for (int i = 0; i < 8; ++i) { const f32x4 p = sp[i]; s1 += p.x + p.z; s2 += p.y + p.w; }
        const float mean = s1 * (1.f / 1024.f); const float var = fmaxf(s2 * (1.f / 1024.f) - mean * mean, 0.f); ST[tid * 2] = mean; ST[tid * 2 + 1] = rsqrtf(var + EPS); }
#pragma unroll
    for (int i = 0; i < 8; ++i) { const int flat = (tid + i * 512) * 4, t = flat >> 7, s = flat & 127;
        f32x4 w = *(const f32x4*)(sw + ((size_t)((l * 8 + h) * 128 + t)) * 128 + s);
        w.x = (s <= t) ? w.x : 0.f; w.y = (s + 1 <= t) ? w.y : 0.f; w.z = (s + 2 <= t) ? w.z : 0.f; w.w = (s + 3 <= t) ? w.w : 0.f;
        v2u o; o.x = pk2(w.x, w.y); o.y = pk2(w.z, w.w); *(LAS v2u*)(Wb + t * 136 + s) = o; }
    __syncthreads();
#pragma unroll
    for (int i = 0; i < 4; ++i) { const int idx = tid + i * 512, s = idx >> 4, c = (idx & 15) * 8;
        float f[8]; unpack8(*(const v4u*)(proj + (size_t)(tok0 + s) * INC + C_SGU + 1024 + h * 128 + c), f);
        const float mean = ST[s * 2], rstd = ST[s * 2 + 1];
        const f32x4 g0 = *(const f32x4*)(lng + l * 1024 + h * 128 + c), g1 = *(const f32x4*)(lng + l * 1024 + h * 128 + c + 4);
        const f32x4 b0 = *(const f32x4*)(lnb + l * 1024 + h * 128 + c), b1 = *(const f32x4*)(lnb + l * 1024 + h * 128 + c + 4);
        float vn[8];
        vn[0] = (f[0] - mean) * rstd * g0.x + b0.x; vn[1] = (f[1] - mean) * rstd * g0.y + b0.y; vn[2] = (f[2] - mean) * rstd * g0.z + b0.z; vn[3] = (f[3] - mean) * rstd * g0.w + b0.w;
        vn[4] = (f[4] - mean) * rstd * g1.x + b1.x; vn[5] = (f[5] - mean) * rstd * g1.y + b1.y; vn[6] = (f[6] - mean) * rstd * g1.z + b1.z; vn[7] = (f[7] - mean) * rstd * g1.w + b1.w;
        const v4u pk = pack8(vn);
#pragma unroll
        for (int e = 0; e < 8; ++e) VnT[(c + e) * 136 + s] = (unsigned short)((pk[e >> 1] >> (16 * (e & 1))) & 0xffffu); }
    __syncthreads();
    const int lane = tid & 63, c16 = lane & 15, quad = lane >> 4;
    pg8::f32x4 acc[8];
#pragma unroll
    for (int mt = 0; mt < 8; ++mt) acc[mt] = (pg8::f32x4){0.f, 0.f, 0.f, 0.f};
    const int ks_end = (wave >> 1) + 1;
#pragma unroll 1
    for (int ks = 0; ks < ks_end; ++ks) {
        const pg8::bf16x8 bq = *(const LAS pg8::bf16x8*)((LAS unsigned char*)Wb + (wave * 16 + c16) * 272 + ks * 64 + quad * 16);
#pragma unroll
        for (int mt = 0; mt < 8; ++mt) { const pg8::bf16x8 aq = *(const LAS pg8::bf16x8*)((LAS unsigned char*)VnT + (mt * 16 + c16) * 272 + ks * 64 + quad * 16);
            acc[mt] = __builtin_amdgcn_mfma_f32_16x16x32_bf16(aq, bq, acc[mt], 0, 0, 0); }
    }
    const int t = wave * 16 + c16;
    const float bias = sb[(l * 8 + h) * 128 + t];
#pragma unroll
    for (int mt = 0; mt < 8; ++mt) { const int ch = h * 128 + mt * 16 + quad * 4; const v2u uw = *(const v2u*)(proj + (size_t)(tok0 + t) * INC + C_SGU + ch);
        v2u o; o.x = pk2(bflo(uw.x) * (acc[mt][0] + bias), bfhi(uw.x) * (acc[mt][1] + bias)); o.y = pk2(bflo(uw.y) * (acc[mt][2] + bias), bfhi(uw.y) * (acc[mt][3] + bias));
        *(v2u*)(ys2 + (size_t)(tok0 + t) * 1024 + ch) = o; }
    __syncthreads();
}

__device__ __forceinline__ unsigned xb_ld(unsigned* p);
__device__ __forceinline__ unsigned xb_add(unsigned* p, unsigned v);
constexpr int PEER_RB = 2;
__device__ __forceinline__ void peer_phase(int l, const float* scores, const bf16* xn, const unsigned char* P8U, const unsigned char* P8V, const float* scl, const float* rowss, const float* xio, float* xout, const float* gnext, bf16* hnext, bool has_next,
                                           LAS unsigned char* lds, int lane, int wave, int gw, int NGW, unsigned* lsync, unsigned nloc) {
    LAS int* EL = (LAS int*)(lds + wave * 8192); LAS float* GL = (LAS float*)(lds + wave * 8192 + 2048); LAS int* IL = (LAS int*)(lds + wave * 8192 + 4096);
    for (int wt = gw; wt < 2048; wt += NGW) {
        const int T0 = wt * 4;
#if PROBE_T
#pragma unroll 1
        for (int rpt = 0; rpt < 3; ++rpt)
#endif
        {
            int Kk[16];
#pragma unroll
            for (int j = 0; j < 16; ++j) Kk[j] = (int)0x80000000;
            const v4i* srow = (const v4i*)(scores + (size_t)T0 * 2048 + lane * 128);
#pragma unroll 1
            for (int i4 = 0; i4 < 32; ++i4) { const v4i v = srow[i4];
#pragma unroll
                for (int k = 0; k < 4; ++k) { int key = v[k]; key ^= (key >> 31) & 0x7fffffff; key = (key & ~127) | (127 - (i4 * 4 + k));
#pragma unroll
                    for (int j = 0; j < 16; ++j) { const int hi = max(Kk[j], key); key = min(Kk[j], key); Kk[j] = hi; } } }
            float Lv[16];
#pragma unroll
            for (int j = 0; j < 16; ++j) { IL[lane * 16 + j] = 127 - (Kk[j] & 127); int m = Kk[j] & ~127; m ^= (m >> 31) & 0x7fffffff; Lv[j] = __int_as_float(m); }
            const bool c0 = (lane & 1) == 0;
            float av[16], bv[16];
#pragma unroll
            for (int j = 0; j < 16; ++j) { const float pv = __shfl_xor(Lv[j], 1); av[j] = c0 ? Lv[j] : pv; bv[j] = c0 ? pv : Lv[j]; }
#define CKEY(i, j) ({ int _k = __float_as_int(av[i] + bv[j]); _k ^= (_k >> 31) & 0x7fffffff; (_k & ~255) | (255 - ((i) * 16 + (j))); })
            int Ck[16];
#pragma unroll
            for (int j = 0; j < 16; ++j) Ck[j] = CKEY(0, j);
#define CAND(i, j) do { int _key = CKEY(i, j); _Pragma("unroll") for (int _j = 0; _j < 16; ++_j) { const int _hi = max(Ck[_j], _key); _key = min(Ck[_j], _key); Ck[_j] = _hi; } } while (0)
            CAND(1, 0); CAND(1, 1); CAND(1, 2); CAND(1, 3); CAND(1, 4); CAND(1, 5); CAND(1, 6); CAND(1, 7);
            CAND(2, 0); CAND(2, 1); CAND(2, 2); CAND(2, 3); CAND(2, 4);
            CAND(3, 0); CAND(3, 1); CAND(3, 2); CAND(3, 3);
            CAND(4, 0); CAND(4, 1); CAND(4, 2);
            CAND(5, 0); CAND(5, 1); CAND(6, 0); CAND(6, 1); CAND(7, 0); CAND(7, 1);
            CAND(8, 0); CAND(9, 0); CAND(10, 0); CAND(11, 0); CAND(12, 0); CAND(13, 0); CAND(14, 0); CAND(15, 0);
#undef CAND
#undef CKEY
            LDS_WAIT();
            float ex[16]; float sum = 0.f; float cv0 = 0.f;
#pragma unroll
            for (int k = 0; k < 16; ++k) { int m = Ck[k] & ~255; m ^= (m >> 31) & 0x7fffffff; const float cv = __int_as_float(m); if (k == 0) cv0 = cv; ex[k] = __builtin_amdgcn_exp2f((cv - cv0) * 1.4426950408889634f); sum += ex[k]; }
            const float inv = 1.f / sum;
            if (c0) { const int slot = (lane >> 1) * 16;
#pragma unroll
                for (int k = 0; k < 16; ++k) { const int code = 255 - (Ck[k] & 255); const int e1 = IL[lane * 16 + (code >> 4)], e2 = IL[(lane + 1) * 16 + (code & 15)];
                    EL[slot + k] = e1 * 128 + e2; GL[slot + k] = ex[k] * inv; } }
            LDS_WAIT();
        }
        {
            LAS int* ES = IL; LAS float* GS = (LAS float*)(IL + 512);
#pragma unroll 1
            for (int tl = 0; tl < 4; ++tl) {
                const int e0 = EL[tl * 128 + lane], e1 = EL[tl * 128 + 64 + lane]; const float g0 = GL[tl * 128 + lane], g1 = GL[tl * 128 + 64 + lane];
                int r0 = 0, r1 = 0;
#pragma unroll 4
                for (int j4 = 0; j4 < 32; ++j4) { const v4i ej = *(const LAS v4i*)(EL + tl * 128 + j4 * 4);
#pragma unroll
                    for (int k = 0; k < 4; ++k) { const int j = j4 * 4 + k;
                        r0 += ((ej[k] < e0) || (ej[k] == e0 && j < lane)) ? 1 : 0; r1 += ((ej[k] < e1) || (ej[k] == e1 && j < lane + 64)) ? 1 : 0; } }
                ES[tl * 128 + r0] = e0; GS[tl * 128 + r0] = g0; ES[tl * 128 + r1] = e1; GS[tl * 128 + r1] = g1;
            }
            LDS_WAIT();
        }
#pragma unroll 1
        for (int tl = 0; tl < 4; ++tl) {
            if (NGW == 2048) __syncthreads();
            const int tok = T0 + tl;
            const float rstd_t = rsqrtf(wave_sum(lane < 32 ? rowss[(size_t)tok * 32 + lane] : 0.f) * (1.f / 2048.f) + EPS);
            float xf[32];
            { const v4u* xp = (const v4u*)(xn + (size_t)tok * 2048);
#pragma unroll
              for (int j = 0; j < 2; ++j) { unpack8(xp[j * 128 + lane * 2], xf + j * 16); unpack8(xp[j * 128 + lane * 2 + 1], xf + j * 16 + 8); } }
            float out[32];
#pragma unroll
            for (int i = 0; i < 32; ++i) out[i] = 0.f;
#define PEER_LOAD(KB, UW, VW, SU, SV, GT) do { \
                _Pragma("unroll") for (int r = 0; r < PEER_RB; ++r) { const int e_ = __builtin_amdgcn_readfirstlane(IL[tl * 128 + (KB) * PEER_RB + r]); GT[r] = ((LAS float*)(IL + 512))[tl * 128 + (KB) * PEER_RB + r]; \
                    const v4u* up = (const v4u*)(P8U + ((size_t)l * 16384 + e_) * 2048); UW[r][0] = up[lane]; UW[r][1] = up[64 + lane]; SU[r] = scl[l * 16384 + e_]; \
                    const v4u* vp = (const v4u*)(P8V + ((size_t)l * 16384 + e_) * 2048); VW[r][0] = vp[lane]; VW[r][1] = vp[64 + lane]; SV[r] = scl[32768 + l * 16384 + e_]; } } while (0)
#define PEER_COMPUTE(UW, VW, SU, SV, GT) do { float hs[PEER_RB]; \
                _Pragma("unroll") for (int r = 0; r < PEER_RB; ++r) { float s0 = 0.f, s1 = 0.f; \
                    _Pragma("unroll") for (int j = 0; j < 2; ++j) _Pragma("unroll") for (int q = 0; q < 4; ++q) { const int w = (int)UW[r][j][q]; const f32x2 lo = __builtin_amdgcn_cvt_pk_f32_fp8(w, false), hi = __builtin_amdgcn_cvt_pk_f32_fp8(w, true); const float* x = xf + j * 16 + q * 4; \
                        s0 += lo.x * x[0]; s1 += lo.y * x[1]; s0 += hi.x * x[2]; s1 += hi.y * x[3]; } \
                    hs[r] = s0 + s1; } \
                _Pragma("unroll") for (int o = 1; o < 64; o <<= 1) { _Pragma("unroll") for (int r = 0; r < PEER_RB; ++r) hs[r] += __shfl_xor(hs[r], o); } \
                _Pragma("unroll") for (int r = 0; r < PEER_RB; ++r) { const float a = gelu_s(hs[r] * (SU[r] * rstd_t)) * GT[r] * SV[r]; \
                    _Pragma("unroll") for (int j = 0; j < 2; ++j) _Pragma("unroll") for (int q = 0; q < 4; ++q) { const int w = (int)VW[r][j][q]; const f32x2 lo = __builtin_amdgcn_cvt_pk_f32_fp8(w, false), hi = __builtin_amdgcn_cvt_pk_f32_fp8(w, true); float* o = out + j * 16 + q * 4; \
                        o[0] += a * lo.x; o[1] += a * lo.y; o[2] += a * hi.x; o[3] += a * hi.y; } } } while (0)
            {
                v4u uwA[PEER_RB][2], vwA[PEER_RB][2], uwB[PEER_RB][2], vwB[PEER_RB][2]; float suA[PEER_RB], svA[PEER_RB], gtA[PEER_RB], suB[PEER_RB], svB[PEER_RB], gtB[PEER_RB];
                PEER_LOAD(0, uwA, vwA, suA, svA, gtA);
#pragma unroll 1
                for (int kb2 = 0; kb2 < 128 / PEER_RB / 2; ++kb2) {
                    PEER_LOAD(2 * kb2 + 1, uwB, vwB, suB, svB, gtB);
                    PEER_COMPUTE(uwA, vwA, suA, svA, gtA);
                    if (kb2 + 1 < 128 / PEER_RB / 2) PEER_LOAD(2 * kb2 + 2, uwA, vwA, suA, svA, gtA);
                    PEER_COMPUTE(uwB, vwB, suB, svB, gtB);
                }
            }
#undef PEER_LOAD
#undef PEER_COMPUTE
            const float* xr = xio + (size_t)tok * 2048; float* xw = xout + (size_t)tok * 2048; float ss = 0.f;
#pragma unroll
            for (int j = 0; j < 2; ++j)
#pragma unroll
                for (int q = 0; q < 4; ++q) { const f32x4* p = (const f32x4*)xr + j * 256 + lane * 4 + q; f32x4* pw = (f32x4*)xw + j * 256 + lane * 4 + q; f32x4 p0 = *p;
#pragma unroll
                    for (int e2 = 0; e2 < 4; ++e2) { p0[e2] += out[j * 16 + q * 4 + e2]; out[j * 16 + q * 4 + e2] = p0[e2]; ss += p0[e2] * p0[e2]; }
                    *pw = p0; }
            if (has_next) { const float rstd = rsqrtf(wave_sum(ss) * (1.f / 2048.f) + EPS);
#pragma unroll
                for (int j = 0; j < 2; ++j) { float v[16];
#pragma unroll
                    for (int q = 0; q < 4; ++q) { const f32x4 g4 = ((const f32x4*)gnext)[j * 256 + lane * 4 + q];
#pragma unroll
                        for (int e2 = 0; e2 < 4; ++e2) v[q * 4 + e2] = out[j * 16 + q * 4 + e2] * rstd * g4[e2]; }
                    ((v4u*)(hnext + (size_t)tok * 2048))[j * 128 + lane * 2] = pack8(v); ((v4u*)(hnext + (size_t)tok * 2048))[j * 128 + lane * 2 + 1] = pack8(v + 8); } }
        }
        LDS_WAIT();
    }
}

#define XB_TMO      128
#define XB_XCNT(j)  (256  + 64 * (j))
#define XB_XSUB(j)  (1280 + 64 * (j))
#define XB_XGEN(j)  (2304 + 64 * (j))
#define XB_TOP      3328
#define XB_TOPGEN   3392
#define XCD_BAR_WORDS 3456
#define XB_SPIN_CAP (1u << 18)

__device__ __forceinline__ unsigned xb_ld(unsigned* p)              { return __hip_atomic_load(p, __ATOMIC_RELAXED, __HIP_MEMORY_SCOPE_AGENT); }
__device__ __forceinline__ unsigned xb_add(unsigned* p, unsigned v) { return __hip_atomic_fetch_add(p, v, __ATOMIC_RELAXED, __HIP_MEMORY_SCOPE_AGENT); }
__device__ __forceinline__ unsigned xb_xcc_id() { return (unsigned)__builtin_amdgcn_s_getreg((3 << 11) | 20) & 0xFu; }
#define XB_SPIN(cond, bar) do { unsigned _sp = 0; while (cond) { __builtin_amdgcn_s_sleep(1); \
    if ((++_sp & 255u) == 0u) { if (xb_ld(&(bar)[XB_TMO])) break; if (_sp > XB_SPIN_CAP) { atomicAdd(&(bar)[XB_TMO], 1u); break; } } } } while (0)

struct XcdBarrier {
    unsigned* bar; unsigned x;
    volatile LAS unsigned* st;
};

__device__ __forceinline__ XcdBarrier xcd_barrier_post(unsigned* bar, volatile LAS unsigned* st) {
    XcdBarrier b; b.bar = bar; b.x = xb_xcc_id(); b.st = st;
    if (threadIdx.x == 0) (void)xb_add(&bar[XB_XCNT(b.x)], 1u);
    return b;
}
__device__ __forceinline__ void xcd_barrier_complete(unsigned* bar, unsigned x, unsigned& nloc, unsigned& nx) {
    const unsigned G = gridDim.x * gridDim.y * gridDim.z;
    unsigned sum, cnt, mine, sp = 0u;
    for (;;) {
        sum = 0u; cnt = 0u; mine = 0u;
#pragma unroll
        for (unsigned j = 0; j < 16; ++j) { const unsigned c = xb_ld(&bar[XB_XCNT(j)]); sum += c; cnt += (c > 0u) ? 1u : 0u; mine = (j == x) ? c : mine; }
        if (sum == G) break;
        __builtin_amdgcn_s_sleep(1);
        if ((++sp & 255u) == 0u) { if (xb_ld(&bar[XB_TMO])) break; if (sp > XB_SPIN_CAP) { atomicAdd(&bar[XB_TMO], 1u); break; } }
    }
    nloc = mine > 0u ? mine : 1u; nx = cnt > 0u ? cnt : 1u;
}

__device__ __forceinline__ void xcd_barrier(const XcdBarrier& b) {
    asm volatile("s_waitcnt vmcnt(0)" ::: "memory");
    __syncthreads();
    if (threadIdx.x == 0) {
        unsigned* bar = b.bar;
        __builtin_amdgcn_s_waitcnt(0);
        unsigned nloc = b.st[0], nx = b.st[1];
        if (nloc == 0u) { xcd_barrier_complete(bar, b.x, nloc, nx); b.st[0] = nloc; b.st[1] = nx; }
        const unsigned old = xb_add(&bar[XB_XSUB(b.x)], 1u);
        const unsigned gen = old / nloc;
        if (old + 1u == (gen + 1u) * nloc) {
            __builtin_amdgcn_fence(__ATOMIC_RELEASE, "agent");
            asm volatile("s_waitcnt vmcnt(0)" ::: "memory");
            const unsigned og = xb_add(&bar[XB_TOP], 1u);
            const unsigned tg = og / nx;
            if (og + 1u == (tg + 1u) * nx) xb_add(&bar[XB_TOPGEN], 1u);
            else XB_SPIN(xb_ld(&bar[XB_TOPGEN]) == tg, bar);
            __builtin_amdgcn_fence(__ATOMIC_ACQUIRE, "agent");
            xb_add(&bar[XB_XGEN(b.x)], 1u);
            asm volatile("s_waitcnt vmcnt(0)" ::: "memory");
        } else {
            XB_SPIN(xb_ld(&bar[XB_XGEN(b.x)]) == gen, bar);
            __builtin_amdgcn_fence(__ATOMIC_ACQUIRE, "agent");
            asm volatile("s_waitcnt vmcnt(0)" ::: "memory");
        }
    }
    __syncthreads();
}

struct Args { const float* in[27]; float* out; unsigned char* ws; int ph_lo, ph_hi; };
__global__ void __launch_bounds__(NTHR, 2) hybrid_fwd(Args args) {
    extern __shared__ __attribute__((aligned(16))) unsigned char lds_raw[];
    LAS unsigned char* lds = (LAS unsigned char*)lds_raw;
    cg::grid_group grid = cg::this_grid();
    const int G = gridDim.x, NGW = G * 8;
    unsigned char* ws = args.ws;
    float* abar = (float*)(ws + WS_ABAR); bf16* bbt = (bf16*)(ws + WS_BBAR); float* send = (float*)(ws + WS_SEND);
    bf16* Win_t = (bf16*)(ws + WS_WIN); bf16* Wglu_t = (bf16*)(ws + WS_WGLU); bf16* Wbr_t = (bf16*)(ws + WS_WBR); bf16* Wout_t = (bf16*)(ws + WS_WOUT); bf16* Wqk_t = (bf16*)(ws + WS_WQK);
    unsigned char* P8U = ws + WS_PU; unsigned char* P8V = ws + WS_PV; float* scl = (float*)(ws + WS_SCL); float* rowss = (float*)(ws + WS_MTMP); float* sgst = (float*)(ws + WS_MTMP + 4 * MiB); bf16* hbuf = (bf16*)(ws + WS_H); bf16* xnbuf = (bf16*)(ws + WS_XN); bf16* proj = (bf16*)(ws + WS_PROJ);
    bf16* yg = (bf16*)(ws + WS_YG); bf16* ys = (bf16*)(ws + WS_YS); float* mtmp = (float*)(ws + WS_MTMP); bf16* merged = (bf16*)(ws + WS_MERGED); float* scores = (float*)(ws + WS_SCORES);

    volatile LAS unsigned* bst = (volatile LAS unsigned*)(lds + LDS_BYTES - 16);
    if (threadIdx.x < 4) bst[threadIdx.x] = 0u;
    __syncthreads();
    XcdBarrier xbar; xbar.bar = (unsigned*)ws; xbar.x = 0; xbar.st = bst;
    if (args.ph_hi - args.ph_lo > 1) xbar = xcd_barrier_post((unsigned*)ws, bst);
    for (int ph = args.ph_lo; ph < args.ph_hi; ++ph) {
        if (ph > args.ph_lo) { asm volatile("s_waitcnt vmcnt(0)" ::: "memory"); if (ph == args.ph_lo + 1) grid.sync(); else xcd_barrier(xbar);
#if REP_SYNC
            for (int q = 0; q < REP_SYNC; ++q) xcd_barrier(xbar);
#endif
        }
        int nrep = 1;
#if REP_MASK
        { const int key = ph == 0 ? 0 : 1 + (ph - 1) % 8; nrep = ((REP_MASK >> key) & 1) ? 2 : 1; }
#endif
#if REP_MASK
        for (int rep = 0; rep < nrep; ++rep)
#else
        const int rep = 0;
#endif
        {
        int tid_o = threadIdx.x, bx_o = blockIdx.x; asm volatile("" : "+v"(tid_o), "+s"(bx_o));
        const int tid = tid_o, bx = bx_o, lane = tid & 63, wave = __builtin_amdgcn_readfirstlane(tid >> 6), gw = bx * 8 + wave;
        if (ph == 0) {
#if (PH_ON & 1)
#pragma unroll 1
            for (int stage = 0; stage < 2; ++stage) {
            if (stage == ((bx & 1) ? 0 : 1)) {
            { LAS float* KL = (LAS float*)lds; LAS float* WL = (LAS float*)(lds + 128 * 132 * 4);
              for (int it = bx; it < 2 * 512; it += G) { const int l = it >> 9, b16 = (it >> 5) & 15, kk0 = (it & 31) * 64; const int hh = b16 >> 1, cc = b16 & 1;
                  const float* kp = args.in[24] + ((size_t)((l * 2 + cc) * 8 + hh)) * 128 * 128; const float* wq = args.in[23] + (size_t)l * 2048 * 2048;
#pragma unroll
                  for (int i = 0; i < 8; ++i) { const int flat = (tid + i * 512) * 4, row = flat >> 7, col = flat & 127; *(LAS f32x4*)(KL + row * 132 + col) = *(const f32x4*)(kp + flat); }
#pragma unroll
                  for (int i = 0; i < 4; ++i) { const int flat = (tid + i * 512) * 4, row = flat >> 7, col = flat & 127; *(LAS f32x4*)(WL + row * 132 + col) = *(const f32x4*)(wq + (size_t)(kk0 + row) * 2048 + b16 * 128 + col); }
                  __syncthreads();
                  const int n = tid & 127, kg = tid >> 7; float acc[16];
#pragma unroll
                  for (int j = 0; j < 16; ++j) acc[j] = 0.f;
#pragma unroll 2
                  for (int d4 = 0; d4 < 32; ++d4) { const f32x4 kv = *(const LAS f32x4*)(KL + n * 132 + d4 * 4);
#pragma unroll
                      for (int j = 0; j < 16; ++j) { const f32x4 wv = *(const LAS f32x4*)(WL + (kg * 16 + j) * 132 + d4 * 4); acc[j] += (kv.x * wv.x + kv.y * wv.y) + (kv.z * wv.z + kv.w * wv.w); } }
                  bf16* op = Wqk_t + (size_t)l * 2048 * 2048 + (size_t)(b16 * 128 + n) * 2048 + kk0 + kg * 16;
                  *(v4u*)op = pack8(acc); *(v4u*)(op + 8) = pack8(acc + 8);
                  __syncthreads(); } }
            }
            __syncthreads();
            if (stage == 0) {
            { LAS float* scr = (LAS float*)(lds + wave * 16384);
              for (int it = gw; it < 2 * 16384; it += NGW) { const int l = it >> 14; int r = it & 16383;
                  if (r < 10752) { p0_transpose_item(args.in[2] + (size_t)l * 2048 * INC, 2048, INC, Win_t + (size_t)l * INC * 2048, scr, r, lane); continue; } r -= 10752;
                  if (r < 512) { p0_transpose_item(args.in[11] + (size_t)l * 1024 * 1024, 1024, 1024, Wglu_t + (size_t)l * 1024 * 1024, scr, r, lane); continue; } r -= 512;
                  if (r < 3072) { const int n = r >> 10; r &= 1023; p0_transpose_item(args.in[20] + (size_t)(l * 3 + n) * 1024 * 2048, 1024, 2048, Wbr_t + (size_t)(l * 3 + n) * 2048 * 1024, scr, r, lane); continue; } r -= 3072;
                  p0_transpose_item(args.in[21] + (size_t)l * 2048 * 2048, 2048, 2048, Wout_t + (size_t)l * 2048 * 2048, scr, r, lane); } }
            { const size_t gt = (size_t)bx * NTHR + tid;
              { f32x4 vnx[2][4];
                { const int tsel = gw >> 15, within = gw & 32767; const f32x4* src = (const f32x4*)((tsel ? args.in[26] : args.in[25]) + (size_t)within * 2048);
#pragma unroll
                  for (int j = 0; j < 2; ++j)
#pragma unroll
                      for (int q = 0; q < 4; ++q) vnx[j][q] = src[j * 256 + lane * 4 + q]; }
                for (int r = gw; r < 65536; r += NGW) { const int tsel = r >> 15, within = r & 32767;
                  f32x4 v[2][4]; float mx = 0.f;
#pragma unroll
                  for (int j = 0; j < 2; ++j)
#pragma unroll
                      for (int q = 0; q < 4; ++q) v[j][q] = vnx[j][q];
                  { const int rn = (r + NGW < 65536) ? r + NGW : r; const f32x4* srcn = (const f32x4*)(((rn >> 15) ? args.in[26] : args.in[25]) + (size_t)(rn & 32767) * 2048);
#pragma unroll
                    for (int j = 0; j < 2; ++j)
#pragma unroll
                        for (int q = 0; q < 4; ++q) vnx[j][q] = srcn[j * 256 + lane * 4 + q]; }
#pragma unroll
                  for (int j = 0; j < 2; ++j)
#pragma unroll
                      for (int q = 0; q < 4; ++q) mx = fmaxf(mx, fmaxf(fmaxf(fabsf(v[j][q].x), fabsf(v[j][q].y)), fmaxf(fabsf(v[j][q].z), fabsf(v[j][q].w))));
#pragma unroll
                  for (int o = 1; o < 64; o <<= 1) mx = fmaxf(mx, __shfl_xor(mx, o));
                  mx = fmaxf(mx, 1e-30f); const float qs = 440.f / mx;
#pragma unroll
                  for (int j = 0; j < 2; ++j) { v4u o;
#pragma unroll
                      for (int q = 0; q < 4; ++q) { int w = __builtin_amdgcn_cvt_pk_fp8_f32(v[j][q].x * qs, v[j][q].y * qs, 0, false); w = __builtin_amdgcn_cvt_pk_fp8_f32(v[j][q].z * qs, v[j][q].w * qs, w, true); o[q] = (unsigned)w; }
                      ((v4u*)((tsel ? P8V : P8U) + (size_t)within * 2048))[j * 64 + lane] = o; }
                  if (lane == 0) scl[r] = mx * (1.f / 440.f); } }
              if (gt < 8192) {
                  const int idx = (int)gt, lg = idx >> 6;
                  const float are = args.in[3][idx], aim = args.in[4][idx], dt = expf(args.in[10][lg]);
                  const float er = expf(are * dt), ang = aim * dt; const float abr = er * cosf(ang), abi = er * sinf(ang);
                  abar[idx * 2] = abr; abar[idx * 2 + 1] = abi;
                  const float nr = abr - 1.f, ni = abi, den = are * are + aim * aim; const float cr = (nr * are + ni * aim) / den, ci = (ni * are - nr * aim) / den;
                  for (int h = 0; h < 16; ++h) { const float br = args.in[5][(size_t)idx * 16 + h], bi = args.in[6][(size_t)idx * 16 + h];
                      const float bre = cr * br - ci * bi, bim = cr * bi + ci * br; const size_t kb = ((size_t)lg * 128 + 2 * (idx & 63)) * 16 + h;
                      bbt[kb] = (bf16)(pk2(bre, 0.f) & 0xffffu); bbt[kb + 16] = (bf16)(pk2(bim, 0.f) & 0xffffu); } } }
            }
            __syncthreads();
            }
            for (int m = gw; m < M; m += NGW) rms_row_to_bf16(args.in[0] + (size_t)m * D, args.in[1], hbuf + (size_t)m * D, lane);
#endif
        } else {
        const int l = (ph - 1) / 8, sub = (ph - 1) % 8;
        bf16* ys0 = ys; bf16* ys1 = ys + (size_t)M * 1024; bf16* ys2 = ys + (size_t)2 * M * 1024;
        if (sub == 0 && (PH_ON & 2)) {
            pg8::Gemm g{hbuf, Win_t + (size_t)l * INC * 2048, M, INC, 2048}; RangeOrder S; S.base.init(M, INC, G, 0); S.lo = 0; S.hi = (G == 256) ? 1280 : 1344; S.G2 = G; S.c2 = bx;
            EpiProj E{proj, sgst + (size_t)l * M * 32}; pg8::gemm_phase<EpiProj, RangeOrder, true, true>(lds, g, S, E);
        } else if (sub == 1 && (PH_ON & 4)) {
            for (int rp = 0; rp < ((REP_MIX & 1) ? 2 : 1); ++rp)
            for (int it = bx; it < 256; it += G) attn_item(it, l, proj, args.in[13] + l * 64, args.in[14] + l * 64, args.in[15] + l * 16, ys1, lds, tid);
            for (int rp = 0; rp < ((REP_MIX & 2) ? 2 : 1); ++rp)
            for (int it = bx; it < 512; it += G) sgu_item(it, l, proj, sgst + (size_t)l * M * 32, args.in[16], args.in[17], args.in[18], args.in[19], ys2, lds, tid, wave);
            for (int rp = 0; rp < ((REP_MIX & 4) ? 2 : 1); ++rp)
            for (int it = bx; it < 256; it += G) ssm_item<false>(it, l, proj, abar, bbt, args.in[7], args.in[8], args.in[9], send, yg, lds, tid, lane, wave);
        } else if (sub == 2 && (PH_ON & 8)) {
#if PROBE_P
            for (int rpp = 0; rpp < 4; ++rpp)
            for (int it = bx; it < 256; it += G) ssm_item<true>(it, l, proj, abar, bbt, args.in[7], args.in[8], args.in[9], send, yg, lds, tid, lane, wave, 0);
#endif
            for (int it = bx; it < 256; it += G) ssm_item<true>(it, l, proj, abar, bbt, args.in[7], args.in[8], args.in[9], send, yg, lds, tid, lane, wave);
        } else if (sub == 3 && (PH_ON & 16)) {
            pg8::Gemm g{yg, Wglu_t + (size_t)l * 1024 * 1024, M, 1024, 1024}; pg8::StaticOrder S; S.init(M, 1024, G, bx);
            EpiGlu E{yg, args.in[12] + l * 1024, ys0}; pg8::gemm_phase<EpiGlu, pg8::StaticOrder, true, true>(lds, g, S, E);
            if (G == 256) {
                pg8::Gemm g2{hbuf, Win_t + (size_t)l * INC * 2048, M, INC, 2048}; RangeOrder S2; S2.base.init(M, INC, G, 0); S2.lo = 1280; S2.hi = 1344; S2.G2 = G; S2.c2 = (bx + 128) & 255;
                EpiProj E2{proj, sgst + (size_t)l * M * 32}; pg8::gemm_phase<EpiProj, RangeOrder, true, true>(lds, g2, S2, E2); }
        } else if (sub == 4 && (PH_ON & 32)) {
            pg8::Gemm g{ys, Wbr_t + (size_t)l * 3 * 2048 * 1024, 3 * M, 3 * 2048, 1024}; BranchOrder S{G, bx};
            EpiBranch E{proj, merged}; pg8::gemm_phase<EpiBranch, BranchOrder, true, true>(lds, g, S, E);
        } else if (sub == 5 && (PH_ON & 64)) {
            pg8::Gemm g{merged, Wout_t + (size_t)l * 2048 * 2048, M, 2048, 2048}; pg8::StaticOrder S; S.init(M, 2048, G, bx);
            EpiResidNorm E{l == 0 ? args.in[0] : (const float*)args.out, args.out, args.in[22] + l * D, xnbuf, rowss + (size_t)l * M * 32}; pg8::gemm_phase<EpiResidNorm, pg8::StaticOrder, true, true>(lds, g, S, E);
        } else if (sub == 6 && (PH_ON & 256)) {
            pg8::Gemm g{xnbuf, Wqk_t + (size_t)l * 2048 * 2048, M, 2048, 2048}; pg8::StaticOrder S; S.init(M, 2048, G, bx);
            EpiScoreF32 E{scores, rowss + (size_t)l * M * 32}; pg8::gemm_phase<EpiScoreF32, pg8::StaticOrder, true, true>(lds, g, S, E);
        } else if (PH_ON & 512) {
            const bool dry = rep + 1 < nrep;
            peer_phase(l, scores, xnbuf, P8U, P8V, scl, rowss + (size_t)l * M * 32, args.out, dry ? mtmp : args.out, args.in[1] + (l + 1 < DEPTH ? (l + 1) * D : 0), dry ? merged : hbuf, l + 1 < DEPTH, lds, lane, wave, gw, NGW, (unsigned*)ws + 4096 + 64 * xbar.x, bst[0] ? bst[0] : 1u);
        }
        }
        __syncthreads();
        }
    }
}

extern "C" void kernel_launch(void* const* d_in, const int* in_sizes, int n_in, void* d_out, int out_size, void* d_ws, size_t ws_size, hipStream_t stream) {
    static int grid = 0;
    if (grid == 0) {
        if (n_in != 27 || out_size != M * D || ws_size < WS_END) { fprintf(stderr, "kernel_launch: unexpected shapes (n_in %d out %d ws %zu)\n", n_in, out_size, ws_size); grid = -1; return; }
        int dev = 0, cus = 0, per_cu = 0;
        (void)hipGetDevice(&dev); (void)hipDeviceGetAttribute(&cus, hipDeviceAttributeMultiprocessorCount, dev);
        if (hipFuncSetAttribute((const void*)hybrid_fwd, hipFuncAttributeMaxDynamicSharedMemorySize, LDS_BYTES) != hipSuccess) { fprintf(stderr, "kernel_launch: hipFuncSetAttribute failed\n"); grid = -1; return; }
        if (hipOccupancyMaxActiveBlocksPerMultiprocessor(&per_cu, (const void*)hybrid_fwd, NTHR, LDS_BYTES) != hipSuccess || per_cu < 1) { fprintf(stderr, "kernel_launch: occupancy query failed (%d)\n", per_cu); (void)hipGetLastError(); grid = -1; return; }
        grid = cus * per_cu;
    }
    if (grid < 0) return;
    Args a{};
    for (int i = 0; i < 27; ++i) a.in[i] = (const float*)d_in[i];
    a.out = (float*)d_out; a.ws = (unsigned char*)d_ws;
#if N_LAUNCH_MODE == 1
    a.ph_lo = 0; a.ph_hi = NPHASE;
    if (hipMemsetAsync(d_ws, 0, 131072, stream) != hipSuccess) { fprintf(stderr, "kernel_launch: hipMemsetAsync failed\n"); return; }
    void* kargs[] = {&a};
    hipError_t e = hipLaunchCooperativeKernel((const void*)hybrid_fwd, dim3(grid), dim3(NTHR), kargs, LDS_BYTES, stream);
    if (e != hipSuccess) fprintf(stderr, "kernel_launch: cooperative launch failed: %s (grid %d)\n", hipGetErrorString(e), grid);
#else
    (void)hipMemsetAsync(d_ws, 0, 131072, stream);
    for (int ph = 0; ph < NPHASE; ++ph) { a.ph_lo = ph; a.ph_hi = ph + 1; hipLaunchKernelGGL(hybrid_fwd, dim3(grid), dim3(NTHR), LDS_BYTES, stream, a); }
#endif
}
```

```cpp
#include <hip/hip_runtime.h>
#include <hip/hip_cooperative_groups.h>
#include <cstdio>
#include <cstdint>
namespace cg = cooperative_groups;
#define N_LAUNCH_MODE 1
namespace pg8 {
#define PG8_LAS __attribute__((address_space(3)))
typedef unsigned short bf16_t;
typedef short bf16x8 __attribute__((ext_vector_type(8)));
typedef float f32x4 __attribute__((ext_vector_type(4)));
typedef unsigned u32x4 __attribute__((ext_vector_type(4)));
constexpr int BM = 256, BK = 64, HALF = 128, HTB = HALF * BK * 2  , STAGE_BYTES = 8 * HTB, NXCD = 8, WGM = 8;

__host__ __device__ __forceinline__ int lds_byte(int r, int c) { const int st = (r >> 4) * 2 + (c >> 5), rr = r & 15, cc = c & 31, ob = rr * 64 + cc * 2; return st * 1024 + (ob ^ (((ob >> 9) & 1) << 5)); }
__host__ __device__ __forceinline__ void stage_rc(int b, int& R, int& C) { const int st = b / 1024, sb = b % 1024, swz = sb ^ (((sb >> 9) & 1) << 5); R = (st >> 1) * 16 + swz / 64; C = (st & 1) * 32 + (swz % 64) / 2; }
__host__ __device__ __forceinline__ int perm32(int rho) { const int n = rho >> 4, i = rho & 15; return 8 * (i >> 2) + 4 * n + (i & 3); }

struct Unit { int pm, pn; };
struct Gemm { const bf16_t* A; const bf16_t* Bt; int M, N, K; };

struct StaticOrder {
    int nM, nN, nwg, G, c;
    __host__ __device__ void init(int M, int N, int G_, int c_) { nM = M / BM; nN = N / BM; nwg = nM * nN; G = G_; c = c_; }
    __host__ __device__ bool next(int i, Unit& u) const {
        const long L = (long)i * G + c; if (L >= nwg) return false;
        int wgid = (int)L; { const int q = nwg / NXCD, r = nwg % NXCD, xcd = wgid % NXCD, off = wgid / NXCD; wgid = (xcd < r ? xcd * (q + 1) : r * (q + 1) + (xcd - r) * q) + off; }
        const int nig = WGM * nN, gid = wgid / nig, fm = gid * WGM, gsz = (nM - fm) < WGM ? (nM - fm) : WGM;
        u.pm = fm + ((wgid % nig) % gsz); u.pn = (wgid % nig) / gsz; return true;
    }
    __device__ __forceinline__ void a_ready(const Unit&) const {}
    __device__ __forceinline__ void done(const Unit&) const {}
};

__device__ __forceinline__ unsigned cvt_pk_bf16(float lo, float hi) { unsigned r; asm volatile("v_cvt_pk_bf16_f32 %0, %1, %2" : "=v"(r) : "v"(lo), "v"(hi)); return r; }
typedef float f32x2 __attribute__((ext_vector_type(2)));
__device__ __forceinline__ f32x2 gelu_pk(f32x2 v) {
    const f32x2 av = __builtin_elementwise_abs(v), d = av * 0.2316418882f + 1.0f;
    f32x2 t; t.x = __builtin_amdgcn_rcpf(d.x); t.y = __builtin_amdgcn_rcpf(d.y);
    f32x2 q = t * 0.5307027145f + (-0.7265760135f); q = q * t + 0.7107068705f; q = q * t + (-0.142248368f); q = q * t + 0.127414796f; q = q * t;
    const f32x2 s = (v * v) * (-0.72134752044f);
    f32x2 e; e.x = __builtin_amdgcn_exp2f(s.x); e.y = __builtin_amdgcn_exp2f(s.y);
    const f32x2 m = v * (q * e), r = v - m;
    f32x2 o; o.x = v.x < 0.f ? m.x : r.x; o.y = v.y < 0.f ? m.y : r.y; return o;
}
template <class Epi, class Sched, bool ALIGN_EPI = false, bool SP2 = false>
__device__ __forceinline__ void gemm_phase(PG8_LAS unsigned char* lds, const Gemm g, const Sched& S, const Epi& E) {
    int tid_opaque = threadIdx.x; asm volatile("" : "+v"(tid_opaque));
    const int tid = tid_opaque, wid = __builtin_amdgcn_readfirstlane(tid >> 6), lane = tid & 63, wr = wid >> 2, wc = wid & 3, fr = lane & 15, fq = lane >> 4;
    const int K = g.K, nt = K / BK;
    unsigned voffA[2], voffB[2];
#pragma unroll
    for (int i = 0; i < 2; ++i) { int R, C; stage_rc(tid * 16 + i * 8192, R, C); const int Rb = Epi::PERM ? ((R & ~31) + perm32(R & 31)) : R;
        voffA[i] = (unsigned)(R * K + C) * 2u; voffB[i] = (unsigned)(Rb * K + C) * 2u; }
    const size_t kstep = (size_t)(BK * 2);
    const size_t hstep = (size_t)HALF * K * 2;
    const size_t tstep = 2 * hstep;
    const unsigned ldsw = (unsigned)wid * 1024u;
    const int aoff = lds_byte(wr * 64 + fr, fq * 8), boff = lds_byte(wc * 32 + fr, fq * 8);
#define PG8_SA(b, h) (((b) * 2 + (h)) * HTB)
#define PG8_SB(b, h) ((4 + (b) * 2 + (h)) * HTB)
#define PG8_STAGE(bufoff, gbase, voff) do { _Pragma("unroll") for (int _i = 0; _i < 2; ++_i) \
        __builtin_amdgcn_global_load_lds((const unsigned*)((const char*)(gbase) + (voff)[_i]), (PG8_LAS unsigned*)(lds + (bufoff) + ldsw + _i * 8192), 16, 0, 0); } while (0)
#define PG8_LDA(dst, b, h) do { _Pragma("unroll") for (int m = 0; m < 4; ++m) _Pragma("unroll") for (int k = 0; k < 2; ++k) dst[m][k] = *(const PG8_LAS bf16x8*)(lds + PG8_SA(b, h) + aoff + m * 2048 + k * 1024); } while (0)
#define PG8_LDB(dst, b, h) do { _Pragma("unroll") for (int n = 0; n < 2; ++n) _Pragma("unroll") for (int k = 0; k < 2; ++k) dst[n][k] = *(const PG8_LAS bf16x8*)(lds + PG8_SB(b, h) + boff + n * 2048 + k * 1024); } while (0)
#define PG8_MMA(ai, bj, At, Bt) do { __builtin_amdgcn_s_setprio(1); _Pragma("unroll") for (int m = 0; m < 4; ++m) _Pragma("unroll") for (int n = 0; n < 2; ++n) _Pragma("unroll") for (int k = 0; k < 2; ++k) \
        acc[ai][bj][m][n] = __builtin_amdgcn_mfma_f32_16x16x32_bf16(Bt[n][k], At[m][k], acc[ai][bj][m][n], 0, 0, 0); __builtin_amdgcn_s_setprio(0); } while (0)
#define PG8_WAIT_V(n) asm volatile("s_waitcnt vmcnt(" #n ")" ::: "memory")
#define PG8_WAIT_L(n) asm volatile("s_waitcnt lgkmcnt(" #n ")" ::: "memory")
#define PG8_BAR __builtin_amdgcn_s_barrier()
#define PG8_SCHED __builtin_amdgcn_sched_barrier(0)
    Unit cur, nxt; int ui = 0;
    if (!S.next(0, cur)) return;
    f32x4 acc[2][2][4][2];
#pragma unroll
    for (int a = 0; a < 2; ++a)
#pragma unroll
        for (int b = 0; b < 2; ++b)
#pragma unroll
            for (int m = 0; m < 4; ++m)
#pragma unroll
                for (int n = 0; n < 2; ++n) acc[a][b][m][n] = (f32x4){0.f, 0.f, 0.f, 0.f};
    bf16x8 At[4][2], B0[2][2], B1[2][2];
    const char* cA = (const char*)g.A + (size_t)cur.pm * tstep; const char* cB = (const char*)g.Bt + (size_t)cur.pn * tstep;
    S.a_ready(cur);
    if constexpr (SP2) {
        PG8_STAGE(PG8_SB(0, 0), cB, voffB); PG8_STAGE(PG8_SB(0, 1), cB + hstep, voffB); PG8_STAGE(PG8_SA(0, 0), cA, voffA); PG8_STAGE(PG8_SA(0, 1), cA + hstep, voffA);
        if (wr == 1) PG8_BAR;
        PG8_WAIT_V(2); PG8_BAR;
        PG8_STAGE(PG8_SB(1, 0), cB + kstep, voffB); PG8_STAGE(PG8_SA(1, 0), cA + kstep, voffA); PG8_STAGE(PG8_SB(1, 1), cB + hstep + kstep, voffB);
        PG8_WAIT_V(6); PG8_BAR;
    } else {
        PG8_STAGE(PG8_SB(0, 0), cB, voffB); PG8_STAGE(PG8_SA(0, 0), cA, voffA); PG8_STAGE(PG8_SB(0, 1), cB + hstep, voffB); PG8_STAGE(PG8_SA(0, 1), cA + hstep, voffA);
        if (wr == 1) PG8_BAR;
        PG8_WAIT_V(4); PG8_BAR;
        PG8_STAGE(PG8_SB(1, 0), cB + kstep, voffB); PG8_STAGE(PG8_SA(1, 0), cA + kstep, voffA); PG8_STAGE(PG8_SB(1, 1), cB + hstep + kstep, voffB);
        PG8_WAIT_V(6); PG8_BAR;
    }
    for (;;) {
        const bool has_next = S.next(ui + 1, nxt);
        const char* nA = has_next ? (const char*)g.A + (size_t)nxt.pm * tstep : cA; const char* nB = has_next ? (const char*)g.Bt + (size_t)nxt.pn * tstep : cB;
        for (int t = 0; t < nt; t += 2) {
            const bool last = (t == nt - 2);
            const char* a1 = cA + (size_t)(t + 1) * kstep;
            const char* a2 = last ? nA : cA + (size_t)(t + 2) * kstep; const char* b2 = last ? nB : cB + (size_t)(t + 2) * kstep;
            const char* a3 = a2 + kstep; const char* b3 = b2 + kstep;
            if (last && has_next) S.a_ready(nxt);
            if constexpr (SP2) {
            PG8_LDB(B0, 0, 0); PG8_LDB(B1, 0, 1); PG8_SCHED; PG8_LDA(At, 0, 0); PG8_STAGE(PG8_SA(1, 1), a1 + hstep, voffA);
            PG8_WAIT_V(8); PG8_WAIT_L(0); PG8_BAR; PG8_MMA(0, 0, At, B0); PG8_MMA(0, 1, At, B1); PG8_BAR; PG8_SCHED;
            PG8_LDA(At, 0, 1); PG8_STAGE(PG8_SB(0, 0), b2, voffB); PG8_STAGE(PG8_SB(0, 1), b2 + hstep, voffB); PG8_STAGE(PG8_SA(0, 0), a2, voffA);
            PG8_WAIT_V(8); PG8_WAIT_L(0); PG8_BAR; PG8_MMA(1, 0, At, B0); PG8_MMA(1, 1, At, B1); PG8_BAR; PG8_SCHED;
            PG8_LDB(B0, 1, 0); PG8_LDB(B1, 1, 1); PG8_SCHED; PG8_LDA(At, 1, 0); PG8_STAGE(PG8_SA(0, 1), a2 + hstep, voffA);
            PG8_WAIT_V(8); PG8_WAIT_L(0); PG8_BAR; PG8_MMA(0, 0, At, B0); PG8_MMA(0, 1, At, B1); PG8_BAR; PG8_SCHED;
            PG8_LDA(At, 1, 1); PG8_STAGE(PG8_SB(1, 0), b3, voffB); PG8_STAGE(PG8_SB(1, 1), b3 + hstep, voffB); PG8_STAGE(PG8_SA(1, 0), a3, voffA);
            PG8_WAIT_V(8); PG8_WAIT_L(0); PG8_BAR; PG8_MMA(1, 0, At, B0); PG8_MMA(1, 1, At, B1); PG8_BAR; PG8_SCHED;
            } else {
            PG8_LDB(B0, 0, 0); PG8_SCHED; PG8_LDA(At, 0, 0); PG8_STAGE(PG8_SA(1, 1), a1 + hstep, voffA);
            PG8_WAIT_L(8); PG8_BAR; PG8_WAIT_L(0); PG8_MMA(0, 0, At, B0); PG8_BAR; PG8_SCHED;
            PG8_LDB(B1, 0, 1); PG8_STAGE(PG8_SB(0, 0), b2, voffB);
            PG8_BAR; PG8_WAIT_L(0); PG8_MMA(0, 1, At, B1); PG8_BAR;
            PG8_LDA(At, 0, 1); PG8_STAGE(PG8_SA(0, 0), a2, voffA);
            PG8_BAR; PG8_WAIT_L(0); PG8_MMA(1, 0, At, B0); PG8_BAR; PG8_SCHED;
            PG8_STAGE(PG8_SB(0, 1), b2 + hstep, voffB);
            PG8_WAIT_V(6); PG8_BAR; PG8_MMA(1, 1, At, B1); PG8_BAR;
            PG8_LDB(B0, 1, 0); PG8_SCHED; PG8_LDA(At, 1, 0); PG8_STAGE(PG8_SA(0, 1), a2 + hstep, voffA);
            PG8_WAIT_L(8); PG8_BAR; PG8_WAIT_L(0); PG8_MMA(0, 0, At, B0); PG8_BAR; PG8_SCHED;
            PG8_LDB(B1, 1, 1); PG8_STAGE(PG8_SB(1, 0), b3, voffB);
            PG8_BAR; PG8_WAIT_L(0); PG8_MMA(0, 1, At, B1); PG8_BAR;
            PG8_LDA(At, 1, 1); PG8_STAGE(PG8_SA(1, 0), a3, voffA);
            PG8_BAR; PG8_WAIT_L(0); PG8_MMA(1, 0, At, B0); PG8_BAR; PG8_SCHED;
            PG8_STAGE(PG8_SB(1, 1), b3 + hstep, voffB);
            PG8_WAIT_V(6); PG8_BAR; PG8_MMA(1, 1, At, B1); PG8_BAR;
            }
        }
        if constexpr (ALIGN_EPI) { if (wr == 0) PG8_BAR; }
        if constexpr (!Epi::AFTER_DRAIN) { E(acc, cur, wr, wc, fr, fq); S.done(cur); }
        if (!has_next) break;
        if (!(Epi::CHAIN && E.keep(cur))) {
#pragma unroll
        for (int a = 0; a < 2; ++a)
#pragma unroll
            for (int b = 0; b < 2; ++b)
#pragma unroll
                for (int m = 0; m < 4; ++m)
#pragma unroll
                    for (int n = 0; n < 2; ++n) acc[a][b][m][n] = (f32x4){0.f, 0.f, 0.f, 0.f};
        }
        cur = nxt; cA = nA; cB = nB; ++ui;
        if constexpr (ALIGN_EPI) { if (wr == 1) PG8_BAR; }
    }
    PG8_WAIT_V(0);
    if constexpr (!ALIGN_EPI) { if (wr == 0) PG8_BAR; }
    PG8_BAR;
    if constexpr (Epi::AFTER_DRAIN) { E.fused(acc, cur, wr, wc, fr, fq, lds, wid, lane); S.done(cur); }
#undef PG8_SA
#undef PG8_SB
#undef PG8_STAGE
#undef PG8_LDA
#undef PG8_LDB
#undef PG8_MMA
#undef PG8_WAIT_V
#undef PG8_WAIT_L
#undef PG8_BAR
#undef PG8_SCHED
}
}

#ifndef REP_MASK
#define REP_MASK 0
#endif
#ifndef PROBE_T
#define PROBE_T 0
#endif
#ifndef PROBE_P
#define PROBE_P 0
#endif
#ifndef PROBE_S
#define PROBE_S 0
#endif
#ifndef PROBE_D
#define PROBE_D 0
#endif
#ifndef PROBE_Y
#define PROBE_Y 0
#endif
#ifndef REP_SYNC
#define REP_SYNC 0
#endif
#ifndef REP_MIX
#define REP_MIX 0
#endif
#ifndef MIX_ON
#define MIX_ON 7
#endif
#ifndef PH_ON
#define PH_ON 1023
#endif
#ifndef N_LAUNCH_MODE
#define N_LAUNCH_MODE 1
#endif
#define LAS __attribute__((address_space(3)))
typedef unsigned short bf16;
typedef unsigned v4u __attribute__((ext_vector_type(4)));
typedef unsigned v2u __attribute__((ext_vector_type(2)));
typedef int v4i __attribute__((ext_vector_type(4)));
typedef float f32x4 __attribute__((ext_vector_type(4)));
typedef float f32x2 __attribute__((ext_vector_type(2)));

constexpr int NTHR = 512;
constexpr int M = 8192, D = 2048, DEPTH = 2, INC = 10752;
constexpr int C_Q = 1024, C_K = 2048, C_V = 2304, C_SGU = 2560, C_GATE = 4608;
constexpr float EPS = 1e-6f;
constexpr int LDS_BYTES = 147456;
constexpr int NPHASE = 1 + 8 * DEPTH;
constexpr size_t MiB = 1u << 20;
constexpr size_t WS_ABAR = 1 * MiB, WS_BBAR = 2 * MiB, WS_SCL = 3 * MiB, WS_SEND = 4 * MiB, WS_WIN = 8 * MiB, WS_WGLU = 92 * MiB, WS_WBR = 96 * MiB, WS_WOUT = 120 * MiB,
                 WS_WQK = 136 * MiB, WS_PU = 152 * MiB, WS_PV = 280 * MiB, WS_H = 408 * MiB, WS_XN = 440 * MiB, WS_PROJ = 472 * MiB, WS_YG = 640 * MiB,
                 WS_YS = 656 * MiB, WS_MTMP = 704 * MiB, WS_MERGED = 768 * MiB, WS_SCORES = 800 * MiB, WS_END = 864 * MiB;

#define LDS_WAIT() asm volatile("s_waitcnt lgkmcnt(0)" ::: "memory")
typedef __bf16 bf16x2_t __attribute__((ext_vector_type(2)));
__device__ __forceinline__ unsigned pk2(float lo, float hi) { f32x2 v = {lo, hi}; bf16x2_t b = __builtin_convertvector(v, bf16x2_t); return __builtin_bit_cast(unsigned, b); }
__device__ __forceinline__ float bflo(unsigned w) { return __uint_as_float(w << 16); }
__device__ __forceinline__ float bfhi(unsigned w) { return __uint_as_float(w & 0xffff0000u); }
__device__ __forceinline__ void unpack8(const v4u w, float* f) { f[0] = bflo(w.x); f[1] = bfhi(w.x); f[2] = bflo(w.y); f[3] = bfhi(w.y); f[4] = bflo(w.z); f[5] = bfhi(w.z); f[6] = bflo(w.w); f[7] = bfhi(w.w); }
__device__ __forceinline__ v4u pack8(const float* f) { v4u o; o.x = pk2(f[0], f[1]); o.y = pk2(f[2], f[3]); o.z = pk2(f[4], f[5]); o.w = pk2(f[6], f[7]); return o; }
__device__ __forceinline__ float wave_sum(float v) {
#pragma unroll
    for (int o = 1; o < 64; o <<= 1) v += __shfl_xor(v, o);
    return v;
}
__device__ __forceinline__ float gelu_s(float v) {
    const float av = fabsf(v), d = av * 0.2316418882f + 1.0f; const float t = __builtin_amdgcn_rcpf(d);
    float q = t * 0.5307027145f + (-0.7265760135f); q = q * t + 0.7107068705f; q = q * t + (-0.142248368f); q = q * t + 0.127414796f; q = q * t;
    const float e = __builtin_amdgcn_exp2f(v * v * (-0.72134752044f));
    const float m = v * (q * e); return v < 0.f ? m : v - m;
}
__device__ __forceinline__ float sigmoid_s(float v) { return __builtin_amdgcn_rcpf(1.0f + __builtin_amdgcn_exp2f(-1.4426950408889634f * v)); }

__device__ __forceinline__ float ld_acc(const float* p) { return __hip_atomic_load(p, __ATOMIC_RELAXED, __HIP_MEMORY_SCOPE_AGENT); }
struct EpiProj {
    static constexpr bool PERM = true, AFTER_DRAIN = false, CHAIN = false; __device__ __forceinline__ bool keep(const pg8::Unit&) const { return false; } bf16* O; float* sgst;
    __device__ __forceinline__ void operator()(const pg8::f32x4 (&acc)[2][2][4][2], const pg8::Unit& u, int wr, int wc, int fr, int fq) const {
        const int row0 = u.pm * 256 + wr * 64 + fr, col0 = u.pn * 256 + wc * 32 + 8 * fq;
        const int act = u.pn < 10 ? 0 : (u.pn < 18 ? 1 : 2);
        const bool stats = (u.pn >= 14 && u.pn < 18);
#pragma unroll
        for (int ai = 0; ai < 2; ++ai)
#pragma unroll
            for (int m = 0; m < 4; ++m) { bf16* rowp = O + (size_t)(row0 + ai * 128 + m * 16) * INC + col0; float s1 = 0.f, s2 = 0.f;
#pragma unroll
                for (int bj = 0; bj < 2; ++bj) { float v[8];
#pragma unroll
                    for (int e = 0; e < 4; ++e) { v[e] = acc[ai][bj][m][0][e]; v[4 + e] = acc[ai][bj][m][1][e]; }
                    if (act == 1) {
#pragma unroll
                        for (int e = 0; e < 8; ++e) v[e] = gelu_s(v[e]);
                    } else if (act == 2) {
#pragma unroll
                        for (int e = 0; e < 8; ++e) v[e] = sigmoid_s(v[e]);
                    }
                    const v4u pk = pack8(v); *(v4u*)(rowp + bj * 128) = pk;
                    if (stats) { float r8[8]; unpack8(pk, r8);
#pragma unroll
                        for (int e = 0; e < 8; ++e) { s1 += r8[e]; s2 += r8[e] * r8[e]; } } }
                if (stats) { s1 += __shfl_xor(s1, 16); s1 += __shfl_xor(s1, 32); s2 += __shfl_xor(s2, 16); s2 += __shfl_xor(s2, 32);
                    if (fq == 0) *(f32x2*)(sgst + (size_t)(row0 + ai * 128 + m * 16) * 32 + (u.pn - 14) * 8 + wc * 2) = (f32x2){s1, s2}; } }
    }
};
struct EpiGlu {
    static constexpr bool PERM = true, AFTER_DRAIN = false, CHAIN = false; __device__ __forceinline__ bool keep(const pg8::Unit&) const { return false; } const bf16* YG; const float* bias; bf16* O;
    __device__ __forceinline__ void operator()(const pg8::f32x4 (&acc)[2][2][4][2], const pg8::Unit& u, int wr, int wc, int fr, int fq) const {
        const int row0 = u.pm * 256 + wr * 64 + fr, col0 = u.pn * 256 + wc * 32 + 8 * fq;
#pragma unroll
        for (int bj = 0; bj < 2; ++bj) { const f32x4 b0 = *(const f32x4*)(bias + col0 + bj * 128), b1 = *(const f32x4*)(bias + col0 + bj * 128 + 4);
#pragma unroll
            for (int ai = 0; ai < 2; ++ai)
#pragma unroll
                for (int m = 0; m < 4; ++m) { const size_t off = (size_t)(row0 + ai * 128 + m * 16) * 1024 + col0 + bj * 128;
                    float y[8]; unpack8(*(const v4u*)(YG + off), y); float v[8];
#pragma unroll
                    for (int e = 0; e < 4; ++e) { v[e] = y[e] * sigmoid_s(acc[ai][bj][m][0][e] + b0[e]); v[4 + e] = y[4 + e] * sigmoid_s(acc[ai][bj][m][1][e] + b1[e]); }
                    *(v4u*)(O + off) = pack8(v); } }
    }
};
struct EpiBranch {
    static constexpr bool PERM = true, AFTER_DRAIN = false, CHAIN = true; const bf16* proj; bf16* merged;
    __device__ __forceinline__ bool keep(const pg8::Unit& u) const { return (u.pm >> 5) < 2; }
    __device__ __forceinline__ void operator()(pg8::f32x4 (&acc)[2][2][4][2], const pg8::Unit& u, int wr, int wc, int fr, int fq) const {
        const int n = u.pm >> 5, pm = u.pm & 31, pn = u.pn & 7;
        const int row0 = pm * 256 + wr * 64 + fr, col0 = pn * 256 + wc * 32 + 8 * fq;
#pragma unroll
        for (int ai = 0; ai < 2; ++ai)
#pragma unroll
            for (int m = 0; m < 4; ++m) { const int row = row0 + ai * 128 + m * 16;
#pragma unroll
                for (int bj = 0; bj < 2; ++bj) { const int col = col0 + bj * 128; const bf16* gp = proj + (size_t)row * INC + C_GATE + n * 2048 + col;
                    float g[8]; unpack8(*(const v4u*)gp, g);
                    if (n < 2) { float gn[8]; unpack8(*(const v4u*)(gp + 2048), gn);
#pragma unroll
                        for (int e = 0; e < 8; ++e) g[e] = fmaxf(g[e], 1e-30f) * __builtin_amdgcn_rcpf(fmaxf(gn[e], 1e-30f));
#pragma unroll
                        for (int e = 0; e < 4; ++e) { acc[ai][bj][m][0][e] *= g[e]; acc[ai][bj][m][1][e] *= g[4 + e]; }
                    } else { float v[8];
#pragma unroll
                        for (int e = 0; e < 4; ++e) { v[e] = fmaxf(g[e], 1e-30f) * acc[ai][bj][m][0][e]; v[4 + e] = fmaxf(g[4 + e], 1e-30f) * acc[ai][bj][m][1][e]; }
                        *(v4u*)(merged + (size_t)row * 2048 + col) = pack8(v); } } }
    }
};
struct RangeOrder {
    pg8::StaticOrder base; int lo, hi, G2, c2;
    __device__ __forceinline__ bool next(int i, pg8::Unit& u) const { const int L = lo + i * G2 + c2; if (L >= hi) return false; pg8::StaticOrder t = base; t.c = L % base.G; return t.next(L / base.G, u); }
    __device__ __forceinline__ void a_ready(const pg8::Unit&) const {}
    __device__ __forceinline__ void done(const pg8::Unit&) const {}
};
struct BranchOrder {
    int G, c;
    __device__ __forceinline__ bool next(int i, pg8::Unit& u) const { const int L = (i / 3) * G + c; if (L >= 256) return false; const int n = i % 3; u.pm = n * 32 + (L >> 3); u.pn = n * 8 + (L & 7); return true; }
    __device__ __forceinline__ void a_ready(const pg8::Unit&) const {}
    __device__ __forceinline__ void done(const pg8::Unit&) const {}
};
struct EpiResid {
    static constexpr bool PERM = false, AFTER_DRAIN = false, CHAIN = false; __device__ __forceinline__ bool keep(const pg8::Unit&) const { return false; } const float* base; float* out;
    __device__ __forceinline__ void operator()(const pg8::f32x4 (&acc)[2][2][4][2], const pg8::Unit& u, int wr, int wc, int fr, int fq) const {
        const int row0 = u.pm * 256 + wr * 64 + fr, col0 = u.pn * 256 + wc * 32 + 4 * fq;
#pragma unroll
        for (int ai = 0; ai < 2; ++ai)
#pragma unroll
            for (int m = 0; m < 4; ++m) { const size_t off = (size_t)(row0 + ai * 128 + m * 16) * 2048 + col0;
#pragma unroll
                for (int bj = 0; bj < 2; ++bj)
#pragma unroll
                    for (int n = 0; n < 2; ++n) { const f32x4 b = *(const f32x4*)(base + off + bj * 128 + n * 16); f32x4 o;
#pragma unroll
                        for (int e = 0; e < 4; ++e) o[e] = b[e] + acc[ai][bj][m][n][e];
                        *(f32x4*)(out + off + bj * 128 + n * 16) = o; } }
    }
};
struct EpiResidNorm {
    static constexpr bool PERM = false, AFTER_DRAIN = false, CHAIN = false; __device__ __forceinline__ bool keep(const pg8::Unit&) const { return false; } const float* base; float* out; const float* g2; bf16* xnb; float* rowss;
    __device__ __forceinline__ void operator()(const pg8::f32x4 (&acc)[2][2][4][2], const pg8::Unit& u, int wr, int wc, int fr, int fq) const {
        const int row0 = u.pm * 256 + wr * 64 + fr, col0 = u.pn * 256 + wc * 32 + 4 * fq;
#pragma unroll
        for (int ai = 0; ai < 2; ++ai)
#pragma unroll
            for (int m = 0; m < 4; ++m) { const int row = row0 + ai * 128 + m * 16; const size_t off = (size_t)row * 2048 + col0; float ss = 0.f;
#pragma unroll
                for (int bj = 0; bj < 2; ++bj)
#pragma unroll
                    for (int n = 0; n < 2; ++n) { const f32x4 b = *(const f32x4*)(base + off + bj * 128 + n * 16); const f32x4 g = *(const f32x4*)(g2 + col0 + bj * 128 + n * 16); f32x4 o;
#pragma unroll
                        for (int e = 0; e < 4; ++e) { o[e] = b[e] + acc[ai][bj][m][n][e]; ss += o[e] * o[e]; }
                        *(f32x4*)(out + off + bj * 128 + n * 16) = o;
                        v2u w; w.x = pk2(o[0] * g[0], o[1] * g[1]); w.y = pk2(o[2] * g[2], o[3] * g[3]); *(v2u*)(xnb + off + bj * 128 + n * 16) = w; }
                ss += __shfl_xor(ss, 16); ss += __shfl_xor(ss, 32);
                if (fq == 0) rowss[(size_t)row * 32 + u.pn * 4 + wc] = ss; }
    }
};
struct EpiScoreF32 {
    static constexpr bool PERM = false, AFTER_DRAIN = false, CHAIN = false; __device__ __forceinline__ bool keep(const pg8::Unit&) const { return false; } float* out; const float* rowss;
    __device__ __forceinline__ void operator()(const pg8::f32x4 (&acc)[2][2][4][2], const pg8::Unit& u, int wr, int wc, int fr, int fq) const {
        const int row0 = u.pm * 256 + wr * 64 + fr, col0 = u.pn * 256 + wc * 32 + 4 * fq;
#pragma unroll
        for (int ai = 0; ai < 2; ++ai)
#pragma unroll
            for (int m = 0; m < 4; ++m) { const int row = row0 + ai * 128 + m * 16; const size_t off = (size_t)row * 2048 + col0; const f32x4* pp = (const f32x4*)(rowss + (size_t)row * 32) + fq * 2; const f32x4 p0 = pp[0], p1 = pp[1]; float sq = ((p0.x + p0.y) + (p0.z + p0.w)) + ((p1.x + p1.y) + (p1.z + p1.w)); sq += __shfl_xor(sq, 16); sq += __shfl_xor(sq, 32);
                const float rstd = rsqrtf(sq * (1.f / 2048.f) + EPS);
#pragma unroll
                for (int bj = 0; bj < 2; ++bj)
#pragma unroll
                    for (int n = 0; n < 2; ++n) { f32x4 o;
#pragma unroll
                        for (int e = 0; e < 4; ++e) o[e] = acc[ai][bj][m][n][e] * rstd;
                        *(f32x4*)(out + off + bj * 128 + n * 16) = o; } }
    }
};
struct EpiF32 {
    static constexpr bool PERM = false, AFTER_DRAIN = false, CHAIN = false; __device__ __forceinline__ bool keep(const pg8::Unit&) const { return false; } float* out;
    __device__ __forceinline__ void operator()(const pg8::f32x4 (&acc)[2][2][4][2], const pg8::Unit& u, int wr, int wc, int fr, int fq) const {
        const int row0 = u.pm * 256 + wr * 64 + fr, col0 = u.pn * 256 + wc * 32 + 4 * fq;
#pragma unroll
        for (int ai = 0; ai < 2; ++ai)
#pragma unroll
            for (int m = 0; m < 4; ++m) { const size_t off = (size_t)(row0 + ai * 128 + m * 16) * 2048 + col0;
#pragma unroll
                for (int bj = 0; bj < 2; ++bj)
#pragma unroll
                    for (int n = 0; n < 2; ++n) { f32x4 o;
#pragma unroll
                        for (int e = 0; e < 4; ++e) o[e] = acc[ai][bj][m][n][e];
                        *(f32x4*)(out + off + bj * 128 + n * 16) = o; } }
    }
};

__device__ __forceinline__ void p0_transpose_item(const float* __restrict__ W, int K, int N, bf16* WT, LAS float* scr, int item, int lane) {
    const int nblk = N / 32, kb = item / nblk, nb = item % nblk, k0 = 64 * kb, n0 = 32 * nb;
    float wv[32];
#pragma unroll
    for (int i = 0; i < 32; ++i) wv[i] = W[(size_t)(k0 + 2 * i + (lane >> 5)) * N + n0 + (lane & 31)];
#pragma unroll
    for (int i = 0; i < 32; ++i) scr[(2 * i + (lane >> 5)) * 33 + (lane & 31)] = wv[i];
    LDS_WAIT();
    const int c = lane & 7;
#pragma unroll
    for (int j = 0; j < 4; ++j) { const int n = (lane >> 3) + 8 * j; const LAS float* s = scr + (8 * c) * 33 + n;
        v4u o; o.x = pk2(s[0 * 33], s[1 * 33]); o.y = pk2(s[2 * 33], s[3 * 33]); o.z = pk2(s[4 * 33], s[5 * 33]); o.w = pk2(s[6 * 33], s[7 * 33]);
        *(v4u*)(WT + (size_t)(n0 + n) * K + k0 + 8 * c) = o; }
    LDS_WAIT();
}
__device__ __forceinline__ void rms_row_to_bf16(const float* xrow, const float* g, bf16* orow, int lane) {
    const f32x4* xr = (const f32x4*)xrow + lane; const f32x4* gr = (const f32x4*)g + lane;
    f32x4 v[8]; float s = 0.f;
#pragma unroll
    for (int j = 0; j < 8; ++j) { v[j] = xr[64 * j]; s += (v[j].x * v[j].x + v[j].y * v[j].y) + (v[j].z * v[j].z + v[j].w * v[j].w); }
    const float rstd = rsqrtf(wave_sum(s) * (1.f / 2048.f) + EPS);
    v2u* o8 = (v2u*)orow + lane;
#pragma unroll
    for (int j = 0; j < 8; ++j) { const f32x4 gg = gr[64 * j]; v2u o; o.x = pk2(v[j].x * rstd * gg.x, v[j].y * rstd * gg.y); o.y = pk2(v[j].z * rstd * gg.z, v[j].w * rstd * gg.w); o8[64 * j] = o; }
}

typedef short s16x4 __attribute__((ext_vector_type(4)));
template <bool PASS_C>
__device__ __forceinline__ void ssm_item(int item, int l, const bf16* proj, const float* abar, const bf16* bbt, const float* cre, const float* cim, const float* dvec,
                                         float* send, bf16* yg, LAS unsigned char* lds, int tid, int lane, int wave, int nblk = 16) {
    const int b = item >> 7, g = (item >> 1) & 63, c = (item & 1) * 8 + wave;
    const int tok0 = b * 4096 + c * 256;
    LAS unsigned char* UL = lds + wave * 16640; LAS float* BL = (LAS float*)(lds + wave * 16640 + 8192); LAS float* SL = BL;
    const int c16 = lane & 15, quad = lane >> 4;
    { v4u uw[8];
#pragma unroll
      for (int i = 0; i < 4; ++i) { const v4u* up = (const v4u*)(proj + (size_t)(tok0 + i * 64 + lane) * INC + g * 16); uw[2 * i] = up[0]; uw[2 * i + 1] = up[1]; }
#pragma unroll
      for (int i = 0; i < 4; ++i) { *(LAS v4u*)(UL + (i * 64 + lane) * 32) = uw[2 * i]; *(LAS v4u*)(UL + (i * 64 + lane) * 32 + 16) = uw[2 * i + 1]; } }
    const f32x2 a = *(const f32x2*)(abar + (size_t)((l * 64 + g) * 64 + lane) * 2);
    float sr = 0.f, si = 0.f;
    if (PASS_C) {
        float tr = a.x, ti = a.y;
#pragma unroll
        for (int k = 0; k < 8; ++k) { const float nr = tr * tr - ti * ti; ti = 2.f * tr * ti; tr = nr; }
        const float* sp = send + ((size_t)b * 1024 + g) * 128 + lane * 2;
        float pr = 1.f, pi = 0.f;
        f32x2 e[16];
#pragma unroll
        for (int k = 0; k < 16; ++k) { const int cp = c - 1 - k; e[k] = *(const f32x2*)(sp + (size_t)(cp < 0 ? 0 : cp) * 8192); if (cp < 0) e[k] = (f32x2){0.f, 0.f}; }
#pragma unroll
        for (int k = 0; k < 16; ++k) { sr += pr * e[k].x - pi * e[k].y; si += pr * e[k].y + pi * e[k].x; const float npr = pr * tr - pi * ti; pi = pr * ti + pi * tr; pr = npr; }
    }
    v2u bw[8];
#pragma unroll
    for (int nt = 0; nt < 8; ++nt) bw[nt] = *(const v2u*)(bbt + ((size_t)((l * 64 + g) * 128 + nt * 16 + c16)) * 16 + quad * 4);
    v4u cA[4];
    if (PASS_C) {
        const float* cr = cre + (size_t)((l * 64 + g) * 16 + c16) * 64 + quad * 4; const float* ci = cim + (size_t)((l * 64 + g) * 16 + c16) * 64 + quad * 4;
#pragma unroll
        for (int ks = 0; ks < 4; ++ks) { const f32x4 re = *(const f32x4*)(cr + ks * 16), im = *(const f32x4*)(ci + ks * 16);
            cA[ks] = (v4u){pk2(re.x, -im.x), pk2(re.y, -im.y), pk2(re.z, -im.z), pk2(re.w, -im.w)}; }
    }
    f32x4 dd = (f32x4){0.f, 0.f, 0.f, 0.f};
    if (PASS_C) dd = *(const f32x4*)(dvec + l * 1024 + g * 16 + quad * 4);
#pragma unroll 1
    for (int blk = 0; blk < nblk; ++blk) {
        const v2u ua = *(const LAS v2u*)(UL + (blk * 16 + c16) * 32 + quad * 8);
        const s16x4 ua4 = __builtin_bit_cast(s16x4, ua);
#if PROBE_D
#pragma unroll 1
        for (int rpd = 0; rpd < 3; ++rpd)
#endif
#pragma unroll
        for (int nt = 0; nt < 8; ++nt) { const pg8::f32x4 d = __builtin_amdgcn_mfma_f32_16x16x16bf16_1k(ua4, __builtin_bit_cast(s16x4, bw[nt]), (pg8::f32x4){0.f, 0.f, 0.f, 0.f}, 0, 0, 0);
#pragma unroll
            for (int j = 0; j < 4; ++j) BL[(quad * 4 + j) * 132 + nt * 16 + c16] = d[j]; }
        LDS_WAIT();
#if PROBE_S
        const float sr0 = sr, si0 = si;
#pragma unroll 1
        for (int rps = 0; rps < 3; ++rps) { sr = sr0; si = si0; asm volatile("" : "+v"(sr), "+v"(si));
            if (rps > 0) {
#pragma unroll
                for (int nt = 0; nt < 8; ++nt) { const pg8::f32x4 d = __builtin_amdgcn_mfma_f32_16x16x16bf16_1k(ua4, __builtin_bit_cast(s16x4, bw[nt]), (pg8::f32x4){0.f, 0.f, 0.f, 0.f}, 0, 0, 0);
#pragma unroll
                    for (int j = 0; j < 4; ++j) BL[(quad * 4 + j) * 132 + nt * 16 + c16] = d[j]; }
                LDS_WAIT(); }
#endif
        f32x2 bu[16];
#pragma unroll
        for (int t = 0; t < 16; ++t) bu[t] = *(const LAS f32x2*)(BL + t * 132 + 2 * lane);
        LDS_WAIT();
#pragma unroll
        for (int t = 0; t < 16; ++t) {
            const float nr = a.x * sr - a.y * si + bu[t].x; si = a.x * si + a.y * sr + bu[t].y; sr = nr;
            if (PASS_C) *(LAS f32x2*)(SL + t * 132 + 2 * lane) = (f32x2){sr, si}; }
#if PROBE_S
        LDS_WAIT(); }
#endif
        if (PASS_C) {
            LDS_WAIT();
            pg8::f32x4 yacc = (pg8::f32x4){0.f, 0.f, 0.f, 0.f};
#if PROBE_Y
#pragma unroll 1
            for (int rpy = 0; rpy < 3; ++rpy) { yacc = (pg8::f32x4){0.f, 0.f, 0.f, 0.f}; asm volatile("" : "+v"(yacc));
#endif
            f32x4 sv[8];
#pragma unroll
            for (int ks = 0; ks < 4; ++ks) { sv[2 * ks] = *(const LAS f32x4*)(SL + c16 * 132 + ks * 32 + quad * 8); sv[2 * ks + 1] = *(const LAS f32x4*)(SL + c16 * 132 + ks * 32 + quad * 8 + 4); }
            LDS_WAIT();
#pragma unroll
            for (int ks = 0; ks < 4; ++ks) { const v4u sb = (v4u){pk2(sv[2 * ks].x, sv[2 * ks].y), pk2(sv[2 * ks].z, sv[2 * ks].w), pk2(sv[2 * ks + 1].x, sv[2 * ks + 1].y), pk2(sv[2 * ks + 1].z, sv[2 * ks + 1].w)};
                yacc = __builtin_amdgcn_mfma_f32_16x16x32_bf16(__builtin_bit_cast(pg8::bf16x8, cA[ks]), __builtin_bit_cast(pg8::bf16x8, sb), yacc, 0, 0, 0); }
#if PROBE_Y
            }
#endif
            const float y0 = gelu_s(yacc[0] + dd.x * bflo(ua.x)), y1 = gelu_s(yacc[1] + dd.y * bfhi(ua.x)), y2 = gelu_s(yacc[2] + dd.z * bflo(ua.y)), y3 = gelu_s(yacc[3] + dd.w * bfhi(ua.y));
            v2u o; o.x = pk2(y0, y1); o.y = pk2(y2, y3);
            *(v2u*)(yg + (size_t)(tok0 + blk * 16 + c16) * 1024 + g * 16 + quad * 4) = o;
        }
        LDS_WAIT();
    }
    if (!PASS_C) *(f32x2*)(send + ((size_t)((b * 16 + c) * 64 + g) * 64 + lane) * 2) = (f32x2){sr, si};
}

__device__ __forceinline__ void attn_item(int item, int l, const bf16* proj, const float* qg, const float* kg, const float* sinks, bf16* ys1, LAS unsigned char* lds, int tid) {
    const int b = item >> 7, n = (item >> 2) & 31, kvh = item & 3;
    LAS unsigned char* KLb = lds;
    LAS unsigned short* VtL = (LAS unsigned short*)(lds + 36864);
    const int tokb = b * 4096 + n * 128 - 128;
#pragma unroll
    for (int i = 0; i < 4; ++i) {
        const int idx = tid + i * 512, row = idx >> 3, ch = idx & 7;
        v4u kw = (v4u){0u, 0u, 0u, 0u}, vw = (v4u){0u, 0u, 0u, 0u};
        if (n > 0 || row >= 128) { const bf16* kp = proj + (size_t)(tokb + row) * INC + C_K + kvh * 64 + ch * 8; kw = *(const v4u*)kp; vw = *(const v4u*)(kp + (C_V - C_K)); }
        float kf[8]; unpack8(kw, kf);
        float ss = 0.f;
#pragma unroll
        for (int e = 0; e < 8; ++e) ss += kf[e] * kf[e];
        ss += __shfl_xor(ss, 1); ss += __shfl_xor(ss, 2); ss += __shfl_xor(ss, 4);
        const float r = rsqrtf(ss * (1.f / 64.f) + EPS);
        const f32x4 g0 = *(const f32x4*)(kg + ch * 8), g1 = *(const f32x4*)(kg + ch * 8 + 4);
        kf[0] *= r * g0.x; kf[1] *= r * g0.y; kf[2] *= r * g0.z; kf[3] *= r * g0.w; kf[4] *= r * g1.x; kf[5] *= r * g1.y; kf[6] *= r * g1.z; kf[7] *= r * g1.w;
        *(LAS v4u*)(KLb + row * 144 + ch * 16) = pack8(kf);
#pragma unroll
        for (int e = 0; e < 8; ++e) VtL[(ch * 8 + e) * 264 + row] = (unsigned short)((vw[e >> 1] >> (16 * (e & 1))) & 0xffffu);
    }
    float gkmax = 0.f;
#pragma unroll 8
    for (int d = 0; d < 64; ++d) gkmax = fmaxf(gkmax, fabsf(kg[d]));
    const float LOG2E = 1.4426950408889634f;
    __syncthreads();
    const int lane = tid & 63, w = tid >> 6, c16 = lane & 15, quad = lane >> 4;
    const int g = w >> 1, tq0 = (w & 1) * 64, qh = kvh * 4 + g;
    const float sink2 = sinks[qh] * LOG2E;
#pragma unroll 1
    for (int qt = 0; qt < 4; ++qt) {
        const int tmin = tq0 + qt * 16, t = tmin + c16, tok = b * 4096 + n * 128 + t;
        float qv[16];
        { const bf16* qp = proj + (size_t)tok * INC + C_Q + qh * 64; unpack8(*(const v4u*)(qp + quad * 8), qv); unpack8(*(const v4u*)(qp + 32 + quad * 8), qv + 8); }
        float ss = 0.f;
#pragma unroll
        for (int e = 0; e < 16; ++e) ss += qv[e] * qv[e];
        ss += __shfl_xor(ss, 16); ss += __shfl_xor(ss, 32);
        const float r = rsqrtf(ss * (1.f / 64.f) + EPS) * (0.125f * LOG2E);
        float qn2 = 0.f;
#pragma unroll
        for (int e = 0; e < 8; ++e) { qv[e] *= r * qg[quad * 8 + e]; qv[8 + e] *= r * qg[32 + quad * 8 + e]; qn2 += qv[e] * qv[e] + qv[8 + e] * qv[8 + e]; }
        qn2 += __shfl_xor(qn2, 16); qn2 += __shfl_xor(qn2, 32);
        const float Mb2 = fmaxf(sqrtf(qn2) * 8.f * gkmax, sink2);
        pg8::bf16x8 qB[2];
        qB[0] = __builtin_bit_cast(pg8::bf16x8, pack8(qv)); qB[1] = __builtin_bit_cast(pg8::bf16x8, pack8(qv + 8));
        pg8::f32x4 oacc[4];
#pragma unroll
        for (int dt = 0; dt < 4; ++dt) oacc[dt] = (pg8::f32x4){0.f, 0.f, 0.f, 0.f};
        float lsum = 0.f;
        int p_lo = (tmin + 1) >> 5; const int p_hi = (tmin + 143) >> 5;
        if (n == 0 && p_lo < 4) p_lo = 4;
#pragma unroll 1
        for (int p = p_lo; p <= p_hi; ++p) {
            pg8::f32x4 sacc[2];
#pragma unroll
            for (int tt = 0; tt < 2; ++tt) { sacc[tt] = (pg8::f32x4){0.f, 0.f, 0.f, 0.f};
#pragma unroll
                for (int ks = 0; ks < 2; ++ks) { const pg8::bf16x8 a = *(const LAS pg8::bf16x8*)(KLb + ((2 * p + tt) * 16 + c16) * 144 + ks * 64 + quad * 16);
                    sacc[tt] = __builtin_amdgcn_mfma_f32_16x16x32_bf16(a, qB[ks], sacc[tt], 0, 0, 0); } }
            float pe[8];
#pragma unroll
            for (int tt = 0; tt < 2; ++tt)
#pragma unroll
                for (int j = 0; j < 4; ++j) { const int kb = (2 * p + tt) * 16 + quad * 4 + j; const bool valid = (kb >= t + 1) && (kb <= t + 128) && (n > 0 || kb >= 128);
                    const float pv = valid ? __builtin_amdgcn_exp2f(sacc[tt][j] - Mb2) : 0.f; pe[tt * 4 + j] = pv; lsum += pv; }
            const pg8::bf16x8 pb = __builtin_bit_cast(pg8::bf16x8, pack8(pe));
#pragma unroll
            for (int dt = 0; dt < 4; ++dt) { const LAS unsigned short* vp = VtL + (dt * 16 + c16) * 264 + p * 32 + quad * 4;
                const v2u lo = *(const LAS v2u*)vp, hi = *(const LAS v2u*)(vp + 16);
                const pg8::bf16x8 a = __builtin_bit_cast(pg8::bf16x8, (v4u){lo.x, lo.y, hi.x, hi.y});
                oacc[dt] = __builtin_amdgcn_mfma_f32_16x16x32_bf16(a, pb, oacc[dt], 0, 0, 0); }
        }
        lsum += __shfl_xor(lsum, 16); lsum += __shfl_xor(lsum, 32);
        const float inv = 1.f / (lsum + __builtin_amdgcn_exp2f(sink2 - Mb2));
        bf16* op = ys1 + (size_t)tok * 1024 + qh * 64 + quad * 4;
#pragma unroll
        for (int dt = 0; dt < 4; ++dt) { v2u o; o.x = pk2(oacc[dt][0] * inv, oacc[dt][1] * inv); o.y = pk2(oacc[dt][2] * inv, oacc[dt][3] * inv); *(v2u*)(op + dt * 16) = o; }
    }
    __syncthreads();
}

__device__ __forceinline__ void sgu_item(int item, int l, const bf16* proj, const float* sgst, const float* lng, const float* lnb, const float* sw, const float* sb, bf16* ys2, LAS unsigned char* lds, int tid, int wave) {
    const int b = item >> 8, nc = (item >> 3) & 31, h = item & 7;
    const int tok0 = b * 4096 + nc * 128;
    LAS unsigned short* VnT = (LAS unsigned short*)lds;
    LAS unsigned short* Wb = (LAS unsigned short*)(lds + 34816);
    LAS float* ST = (LAS float*)(lds + 69632);
    if (tid < 128) { const f32x4* sp = (const f32x4*)(sgst + (size_t)(tok0 + tid) * 32); float s1 = 0.f, s2 = 0.f;
#pragma unroll
        for (int i = 0; i < 8; ++i) { const f32x4 p = sp[i]; s1 += p.x + p.z; s2 += p.y + p.w; }
        const float mean = s1 * (1.f / 1024.f); const float var = fmaxf(s2 * (1.f / 1024.f) - mean * mean, 0.f); ST[tid * 2] = mean; ST[tid * 2 + 1] = rsqrtf(var + EPS); }
#pragma unroll
    for (int i = 0; i < 8; ++i) { const int flat = (tid + i * 512) * 4, t = flat >> 7, s = flat & 127;
        f32x4 w = *(const f32x4*)(sw + ((size_t)((l * 8 + h) * 128 + t)) * 128 + s);
        w.x = (s <= t) ? w.x : 0.f; w.y = (s + 1 <= t) ? w.y : 0.f; w.z = (s + 2 <= t) ? w.z : 0.f; w.w = (s + 3 <= t) ? w.w : 0.f;
        v2u o; o.x = pk2(w.x, w.y); o.y = pk2(w.z, w.w); *(LAS v2u*)(Wb + t * 136 + s) = o; }
    __syncthreads();
#pragma unroll
    for (int i = 0; i < 4; ++i) { const int idx = tid + i * 512, s = idx >> 4, c = (idx & 15) * 8;
        float f[8]; unpack8(*(const v4u*)(proj + (size_t)(tok0 + s) * INC + C_SGU + 1024 + h * 128 + c), f);
        const float mean = ST[s * 2], rstd = ST[s * 2 + 1];
        const f32x4 g0 = *(const f32x4*)(lng + l * 1024 + h * 128 + c), g1 = *(const f32x4*)(lng + l * 1024 + h * 128 + c + 4);
        const f32x4 b0 = *(const f32x4*)(lnb + l * 1024 + h * 128 + c), b1 = *(const f32x4*)(lnb + l * 1024 + h * 128 + c + 4);
        float vn[8];
        vn[0] = (f[0] - mean) * rstd * g0.x + b0.x; vn[1] = (f[1] - mean) * rstd * g0.y + b0.y; vn[2] = (f[2] - mean) * rstd * g0.z + b0.z; vn[3] = (f[3] - mean) * rstd * g0.w + b0.w;
        vn[4] = (f[4] - mean) * rstd * g1.x + b1.x; vn[5] = (f[5] - mean) * rstd * g1.y + b1.y; vn[6] = (f[6] - mean) * rstd * g1.z + b1.z; vn[7] = (f[7] - mean) * rstd * g1.w + b1.w;
        const v4u pk = pack8(vn);
#pragma unroll
        for (int e = 0; e < 8; ++e) VnT[(c + e) * 136 + s] = (unsigned short)((pk[e >> 1] >> (16 * (e & 1))) & 0xffffu); }
    __syncthreads();
    const int lane = tid & 63, c16 = lane & 15, quad = lane >> 4;
    pg8::f32x4 acc[8];
#pragma unroll
    for (int mt = 0; mt < 8; ++mt) acc[mt] = (pg8::f32x4){0.f, 0.f, 0.f, 0.f};
    const int ks_end = (wave >> 1) + 1;
#pragma unroll 1
    for (int ks = 0; ks < ks_end; ++ks) {
        const pg8::bf16x8 bq = *(const LAS pg8::bf16x8*)((LAS unsigned char*)Wb + (wave * 16 + c16) * 272 + ks * 64 + quad * 16);
#pragma unroll
        for (int mt = 0; mt < 8; ++mt) { const pg8::bf16x8 aq = *(const LAS pg8::bf16x8*)((LAS unsigned char*)VnT + (mt * 16 + c16) * 272 + ks * 64 + quad * 16);
            acc[mt] = __builtin_amdgcn_mfma_f32_16x16x32_bf16(aq, bq, acc[mt], 0, 0, 0); }
    }
    const int t = wave * 16 + c16;
    const float bias = sb[(l * 8 + h) * 128 + t];
#pragma unroll
    for (int mt = 0; mt < 8; ++mt) { const int ch = h * 128 + mt * 16 + quad * 4; const v2u uw = *(const v2u*)(proj + (size_t)(tok0 + t) * INC + C_SGU + ch);
        v2u o; o.x = pk2(bflo(uw.x) * (acc[mt][0] + bias), bfhi(uw.x) * (acc[mt][1] + bias)); o.y = pk2(bflo(uw.y) * (acc[mt][2] + bias), bfhi(uw.y) * (acc[mt][3] + bias));
        *(v2u*)(ys2 + (size_t)(tok0 + t) * 1024 + ch) = o; }
    __syncthreads();
}

__device__ __forceinline__ unsigned xb_ld(unsigned* p);
__device__ __forceinline__ unsigned xb_add(unsigned* p, unsigned v);
constexpr int PEER_RB = 2;
__device__ __forceinline__ void peer_phase(int l, const float* scores, const bf16* xn, const unsigned char* P8U, const unsigned char* P8V, const float* scl, const float* rowss, const float* xio, float* xout, const float* gnext, bf16* hnext, bool has_next,
                                           LAS unsigned char* lds, int lane, int wave, int gw, int NGW, unsigned* lsync, unsigned nloc) {
    LAS int* EL = (LAS int*)(lds + wave * 8192); LAS float* GL = (LAS float*)(lds + wave * 8192 + 2048); LAS int* IL = (LAS int*)(lds + wave * 8192 + 4096);
    for (int wt = gw; wt < 2048; wt += NGW) {
        const int T0 = wt * 4;
#if PROBE_T
#pragma unroll 1
        for (int rpt = 0; rpt < 3; ++rpt)
#endif
        {
            int Kk[16];
#pragma unroll
            for (int j = 0; j < 16; ++j) Kk[j] = (int)0x80000000;
            const v4i* srow = (const v4i*)(scores + (size_t)T0 * 2048 + lane * 128);
#pragma unroll 1
            for (int i4 = 0; i4 < 32; ++i4) { const v4i v = srow[i4];
#pragma unroll
                for (int k = 0; k < 4; ++k) { int key = v[k]; key ^= (key >> 31) & 0x7fffffff; key = (key & ~127) | (127 - (i4 * 4 + k));
#pragma unroll
                    for (int j = 0; j < 16; ++j) { const int hi = max(Kk[j], key); key = min(Kk[j], key); Kk[j] = hi; } } }
            float Lv[16];
#pragma unroll
            for (int j = 0; j < 16; ++j) { IL[lane * 16 + j] = 127 - (Kk[j] & 127); int m = Kk[j] & ~127; m ^= (m >> 31) & 0x7fffffff; Lv[j] = __int_as_float(m); }
            const bool c0 = (lane & 1) == 0;
            float av[16], bv[16];
#pragma unroll
            for (int j = 0; j < 16; ++j) { const float pv = __shfl_xor(Lv[j], 1); av[j] = c0 ? Lv[j] : pv; bv[j] = c0 ? pv : Lv[j]; }
#define CKEY(i, j) ({ int _k = __float_as_int(av[i] + bv[j]); _k ^= (_k >> 31) & 0x7fffffff; (_k & ~255) | (255 - ((i) * 16 + (j))); })
            int Ck[16];
#pragma unroll
            for (int j = 0; j < 16; ++j) Ck[j] = CKEY(0, j);
#define CAND(i, j) do { int _key = CKEY(i, j); _Pragma("unroll") for (int _j = 0; _j < 16; ++_j) { const int _hi = max(Ck[_j], _key); _key = min(Ck[_j], _key); Ck[_j] = _hi; } } while (0)
            CAND(1, 0); CAND(1, 1); CAND(1, 2); CAND(1, 3); CAND(1, 4); CAND(1, 5); CAND(1, 6); CAND(1, 7);
            CAND(2, 0); CAND(2, 1); CAND(2, 2); CAND(2, 3); CAND(2, 4);
            CAND(3, 0); CAND(3, 1); CAND(3, 2); CAND(3, 3);
            CAND(4, 0); CAND(4, 1); CAND(4, 2);
            CAND(5, 0); CAND(5, 1); CAND(6, 0); CAND(6, 1); CAND(7, 0); CAND(7, 1);
            CAND(8, 0); CAND(9, 0); CAND(10, 0); CAND(11, 0); CAND(12, 0); CAND(13, 0); CAND(14, 0); CAND(15, 0);
#undef CAND
#undef CKEY
            LDS_WAIT();
            float ex[16]; float sum = 0.f; float cv0 = 0.f;
#pragma unroll
            for (int k = 0; k < 16; ++k) { int m = Ck[k] & ~255; m ^= (m >> 31) & 0x7fffffff; const float cv = __int_as_float(m); if (k == 0) cv0 = cv; ex[k] = __builtin_amdgcn_exp2f((cv - cv0) * 1.4426950408889634f); sum += ex[k]; }
            const float inv = 1.f / sum;
            if (c0) { const int slot = (lane >> 1) * 16;
#pragma unroll
                for (int k = 0; k < 16; ++k) { const int code = 255 - (Ck[k] & 255); const int e1 = IL[lane * 16 + (code >> 4)], e2 = IL[(lane + 1) * 16 + (code & 15)];
                    EL[slot + k] = e1 * 128 + e2; GL[slot + k] = ex[k] * inv; } }
            LDS_WAIT();
        }
        {
            LAS int* ES = IL; LAS float* GS = (LAS float*)(IL + 512);
#pragma unroll 1
            for (int tl = 0; tl < 4; ++tl) {
                const int e0 = EL[tl * 128 + lane], e1 = EL[tl * 128 + 64 + lane]; const float g0 = GL[tl * 128 + lane], g1 = GL[tl * 128 + 64 + lane];
                int r0 = 0, r1 = 0;
#pragma unroll 4
                for (int j4 = 0; j4 < 32; ++j4) { const v4i ej = *(const LAS v4i*)(EL + tl * 128 + j4 * 4);
#pragma unroll
                    for (int k = 0; k < 4; ++k) { const int j = j4 * 4 + k;
                        r0 += ((ej[k] < e0) || (ej[k] == e0 && j < lane)) ? 1 : 0; r1 += ((ej[k] < e1) || (ej[k] == e1 && j < lane + 64)) ? 1 : 0; } }
                ES[tl * 128 + r0] = e0; GS[tl * 128 + r0] = g0; ES[tl * 128 + r1] = e1; GS[tl * 128 + r1] = g1;
            }
            LDS_WAIT();
        }
#pragma unroll 1
        for (int tl = 0; tl < 4; ++tl) {
            if (NGW == 2048) __syncthreads();
            const int tok = T0 + tl;
            const float rstd_t = rsqrtf(wave_sum(lane < 32 ? rowss[(size_t)tok * 32 + lane] : 0.f) * (1.f / 2048.f) + EPS);
            float xf[32];
            { const v4u* xp = (const v4u*)(xn + (size_t)tok * 2048);
#pragma unroll
              for (int j = 0; j < 2; ++j) { unpack8(xp[j * 128 + lane * 2], xf + j * 16); unpack8(xp[j * 128 + lane * 2 + 1], xf + j * 16 + 8); } }
            float out[32];
#pragma unroll
            for (int i = 0; i < 32; ++i) out[i] = 0.f;
#define PEER_LOAD(KB, UW, VW, SU, SV, GT) do { \
                _Pragma("unroll") for (int r = 0; r < PEER_RB; ++r) { const int e_ = __builtin_amdgcn_readfirstlane(IL[tl * 128 + (KB) * PEER_RB + r]); GT[r] = ((LAS float*)(IL + 512))[tl * 128 + (KB) * PEER_RB + r]; \
                    const v4u* up = (const v4u*)(P8U + ((size_t)l * 16384 + e_) * 2048); UW[r][0] = up[lane]; UW[r][1] = up[64 + lane]; SU[r] = scl[l * 16384 + e_]; \
                    const v4u* vp = (const v4u*)(P8V + ((size_t)l * 16384 + e_) * 2048); VW[r][0] = vp[lane]; VW[r][1] = vp[64 + lane]; SV[r] = scl[32768 + l * 16384 + e_]; } } while (0)
#define PEER_COMPUTE(UW, VW, SU, SV, GT) do { float hs[PEER_RB]; \
                _Pragma("unroll") for (int r = 0; r < PEER_RB; ++r) { float s0 = 0.f, s1 = 0.f; \
                    _Pragma("unroll") for (int j = 0; j < 2; ++j) _Pragma("unroll") for (int q = 0; q < 4; ++q) { const int w = (int)UW[r][j][q]; const f32x2 lo = __builtin_amdgcn_cvt_pk_f32_fp8(w, false), hi = __builtin_amdgcn_cvt_pk_f32_fp8(w, true); const float* x = xf + j * 16 + q * 4; \
                        s0 += lo.x * x[0]; s1 += lo.y * x[1]; s0 += hi.x * x[2]; s1 += hi.y * x[3]; } \
                    hs[r] = s0 + s1; } \
                _Pragma("unroll") for (int o = 1; o < 64; o <<= 1) { _Pragma("unroll") for (int r = 0; r < PEER_RB; ++r) hs[r] += __shfl_xor(hs[r], o); } \
                _Pragma("unroll") for (int r = 0; r < PEER_RB; ++r) { const float a = gelu_s(hs[r] * (SU[r] * rstd_t)) * GT[r] * SV[r]; \
                    _Pragma("unroll") for (int j = 0; j < 2; ++j) _Pragma("unroll") for (int q = 0; q < 4; ++q) { const int w = (int)VW[r][j][q]; const f32x2 lo = __builtin_amdgcn_cvt_pk_f32_fp8(w, false), hi = __builtin_amdgcn_cvt_pk_f32_fp8(w, true); float* o = out + j * 16 + q * 4; \
                        o[0] += a * lo.x; o[1] += a * lo.y; o[2] += a * hi.x; o[3] += a * hi.y; } } } while (0)
            {
                v4u uwA[PEER_RB][2], vwA[PEER_RB][2], uwB[PEER_RB][2], vwB[PEER_RB][2]; float suA[PEER_RB], svA[PEER_RB], gtA[PEER_RB], suB[PEER_RB], svB[PEER_RB], gtB[PEER_RB];
                PEER_LOAD(0, uwA, vwA, suA, svA, gtA);
#pragma unroll 1
                for (int kb2 = 0; kb2 < 128 / PEER_RB / 2; ++kb2) {
                    PEER_LOAD(2 * kb2 + 1, uwB, vwB, suB, svB, gtB);
                    PEER_COMPUTE(uwA, vwA, suA, svA, gtA);
                    if (kb2 + 1 < 128 / PEER_RB / 2) PEER_LOAD(2 * kb2 + 2, uwA, vwA, suA, svA, gtA);
                    PEER_COMPUTE(uwB, vwB, suB, svB, gtB);
                }
            }
#undef PEER_LOAD
#undef PEER_COMPUTE
            const float* xr = xio + (size_t)tok * 2048; float* xw = xout + (size_t)tok * 2048; float ss = 0.f;
#pragma unroll
            for (int j = 0; j < 2; ++j)
#pragma unroll
                for (int q = 0; q < 4; ++q) { const f32x4* p = (const f32x4*)xr + j * 256 + lane * 4 + q; f32x4* pw = (f32x4*)xw + j * 256 + lane * 4 + q; f32x4 p0 = *p;
#pragma unroll
                    for (int e2 = 0; e2 < 4; ++e2) { p0[e2] += out[j * 16 + q * 4 + e2]; out[j * 16 + q * 4 + e2] = p0[e2]; ss += p0[e2] * p0[e2]; }
                    *pw = p0; }
            if (has_next) { const float rstd = rsqrtf(wave_sum(ss) * (1.f / 2048.f) + EPS);
#pragma unroll
                for (int j = 0; j < 2; ++j) { float v[16];
#pragma unroll
                    for (int q = 0; q < 4; ++q) { const f32x4 g4 = ((const f32x4*)gnext)[j * 256 + lane * 4 + q];
#pragma unroll
                        for (int e2 = 0; e2 < 4; ++e2) v[q * 4 + e2] = out[j * 16 + q * 4 + e2] * rstd * g4[e2]; }
                    ((v4u*)(hnext + (size_t)tok * 2048))[j * 128 + lane * 2] = pack8(v); ((v4u*)(hnext + (size_t)tok * 2048))[j * 128 + lane * 2 + 1] = pack8(v + 8); } }
        }
        LDS_WAIT();
    }
}

#define XB_TMO      128
#define XB_XCNT(j)  (256  + 64 * (j))
#define XB_XSUB(j)  (1280 + 64 * (j))
#define XB_XGEN(j)  (2304 + 64 * (j))
#define XB_TOP      3328
#define XB_TOPGEN   3392
#define XCD_BAR_WORDS 3456
#define XB_SPIN_CAP (1u << 18)

__device__ __forceinline__ unsigned xb_ld(unsigned* p)              { return __hip_atomic_load(p, __ATOMIC_RELAXED, __HIP_MEMORY_SCOPE_AGENT); }
__device__ __forceinline__ unsigned xb_add(unsigned* p, unsigned v) { return __hip_atomic_fetch_add(p, v, __ATOMIC_RELAXED, __HIP_MEMORY_SCOPE_AGENT); }
__device__ __forceinline__ unsigned xb_xcc_id() { return (unsigned)__builtin_amdgcn_s_getreg((3 << 11) | 20) & 0xFu; }
#define XB_SPIN(cond, bar) do { unsigned _sp = 0; while (cond) { __builtin_amdgcn_s_sleep(1); \
    if ((++_sp & 255u) == 0u) { if (xb_ld(&(bar)[XB_TMO])) break; if (_sp > XB_SPIN_CAP) { atomicAdd(&(bar)[XB_TMO], 1u); break; } } } } while (0)

struct XcdBarrier {
    unsigned* bar; unsigned x;
    volatile LAS unsigned* st;
};

__device__ __forceinline__ XcdBarrier xcd_barrier_post(unsigned* bar, volatile LAS unsigned* st) {
    XcdBarrier b; b.bar = bar; b.x = xb_xcc_id(); b.st = st;
    if (threadIdx.x == 0) (void)xb_add(&bar[XB_XCNT(b.x)], 1u);
    return b;
}
__device__ __forceinline__ void xcd_barrier_complete(unsigned* bar, unsigned x, unsigned& nloc, unsigned& nx) {
    const unsigned G = gridDim.x * gridDim.y * gridDim.z;
    unsigned sum, cnt, mine, sp = 0u;
    for (;;) {
        sum = 0u; cnt = 0u; mine = 0u;
#pragma unroll
        for (unsigned j = 0; j < 16; ++j) { const unsigned c = xb_ld(&bar[XB_XCNT(j)]); sum += c; cnt += (c > 0u) ? 1u : 0u; mine = (j == x) ? c : mine; }
        if (sum == G) break;
        __builtin_amdgcn_s_sleep(1);
        if ((++sp & 255u) == 0u) { if (xb_ld(&bar[XB_TMO])) break; if (sp > XB_SPIN_CAP) { atomicAdd(&bar[XB_TMO], 1u); break; } }
    }
    nloc = mine > 0u ? mine : 1u; nx = cnt > 0u ? cnt : 1u;
}

__device__ __forceinline__ void xcd_barrier(const XcdBarrier& b) {
    asm volatile("s_waitcnt vmcnt(0)" ::: "memory");
    __syncthreads();
    if (threadIdx.x == 0) {
        unsigned* bar = b.bar;
        __builtin_amdgcn_s_waitcnt(0);
        unsigned nloc = b.st[0], nx = b.st[1];
        if (nloc == 0u) { xcd_barrier_complete(bar, b.x, nloc, nx); b.st[0] = nloc; b.st[1] = nx; }
        const unsigned old = xb_add(&bar[XB_XSUB(b.x)], 1u);
        const unsigned gen = old / nloc;
        if (old + 1u == (gen + 1u) * nloc) {
            __builtin_amdgcn_fence(__ATOMIC_RELEASE, "agent");
            asm volatile("s_waitcnt vmcnt(0)" ::: "memory");
            const unsigned og = xb_add(&bar[XB_TOP], 1u);
            const unsigned tg = og / nx;
            if (og + 1u == (tg + 1u) * nx) xb_add(&bar[XB_TOPGEN], 1u);
            else XB_SPIN(xb_ld(&bar[XB_TOPGEN]) == tg, bar);
            __builtin_amdgcn_fence(__ATOMIC_ACQUIRE, "agent");
            xb_add(&bar[XB_XGEN(b.x)], 1u);
            asm volatile("s_waitcnt vmcnt(0)" ::: "memory");
        } else {
            XB_SPIN(xb_ld(&bar[XB_XGEN(b.x)]) == gen, bar);
            __builtin_amdgcn_fence(__ATOMIC_ACQUIRE, "agent");
            asm volatile("s_waitcnt vmcnt(0)" ::: "memory");
        }
    }
    __syncthreads();
}

struct Args { const float* in[27]; float* out; unsigned char* ws; int ph_lo, ph_hi; };
__global__ void __launch_bounds__(NTHR, 2) hybrid_fwd(Args args) {
    extern __shared__ __attribute__((aligned(16))) unsigned char lds_raw[];
    LAS unsigned char* lds = (LAS unsigned char*)lds_raw;
    cg::grid_group grid = cg::this_grid();
    const int G = gridDim.x, NGW = G * 8;
    unsigned char* ws = args.ws;
    float* abar = (float*)(ws + WS_ABAR); bf16* bbt = (bf16*)(ws + WS_BBAR); float* send = (float*)(ws + WS_SEND);
    bf16* Win_t = (bf16*)(ws + WS_WIN); bf16* Wglu_t = (bf16*)(ws + WS_WGLU); bf16* Wbr_t = (bf16*)(ws + WS_WBR); bf16* Wout_t = (bf16*)(ws + WS_WOUT); bf16* Wqk_t = (bf16*)(ws + WS_WQK);
    unsigned char* P8U = ws + WS_PU; unsigned char* P8V = ws + WS_PV; float* scl = (float*)(ws + WS_SCL); float* rowss = (float*)(ws + WS_MTMP); float* sgst = (float*)(ws + WS_MTMP + 4 * MiB); bf16* hbuf = (bf16*)(ws + WS_H); bf16* xnbuf = (bf16*)(ws + WS_XN); bf16* proj = (bf16*)(ws + WS_PROJ);
    bf16* yg = (bf16*)(ws + WS_YG); bf16* ys = (bf16*)(ws + WS_YS); float* mtmp = (float*)(ws + WS_MTMP); bf16* merged = (bf16*)(ws + WS_MERGED); float* scores = (float*)(ws + WS_SCORES);

    volatile LAS unsigned* bst = (volatile LAS unsigned*)(lds + LDS_BYTES - 16);
    if (threadIdx.x < 4) bst[threadIdx.x] = 0u;
    __syncthreads();
    XcdBarrier xbar; xbar.bar = (unsigned*)ws; xbar.x = 0; xbar.st = bst;
    if (args.ph_hi - args.ph_lo > 1) xbar = xcd_barrier_post((unsigned*)ws, bst);
    for (int ph = args.ph_lo; ph < args.ph_hi; ++ph) {
        if (ph > args.ph_lo) { asm volatile("s_waitcnt vmcnt(0)" ::: "memory"); if (ph == args.ph_lo + 1) grid.sync(); else xcd_barrier(xbar);
#if REP_SYNC
            for (int q = 0; q < REP_SYNC; ++q) xcd_barrier(xbar);
#endif
        }
        int nrep = 1;
#if REP_MASK
        { const int key = ph == 0 ? 0 : 1 + (ph - 1) % 8; nrep = ((REP_MASK >> key) & 1) ? 2 : 1; }
#endif
#if REP_MASK
        for (int rep = 0; rep < nrep; ++rep)
#else
        const int rep = 0;
#endif
        {
        int tid_o = threadIdx.x, bx_o = blockIdx.x; asm volatile("" : "+v"(tid_o), "+s"(bx_o));
        const int tid = tid_o, bx = bx_o, lane = tid & 63, wave = __builtin_amdgcn_readfirstlane(tid >> 6), gw = bx * 8 + wave;
        if (ph == 0) {
#if (PH_ON & 1)
#pragma unroll 1
            for (int stage = 0; stage < 2; ++stage) {
            if (stage == ((bx & 1) ? 0 : 1)) {
            { LAS unsigned short* KLb = (LAS unsigned short*)lds; LAS unsigned short* WLb = (LAS unsigned short*)(lds + 34816);
              for (int it = bx; it < 2 * 512; it += G) { const int l = it >> 9, b16 = (it >> 5) & 15, kk0 = (it & 31) * 64; const int hh = b16 >> 1, cc = b16 & 1;
                  const float* kp = args.in[24] + ((size_t)((l * 2 + cc) * 8 + hh)) * 128 * 128; const float* wq = args.in[23] + (size_t)l * 2048 * 2048;
#pragma unroll
                  for (int i = 0; i < 8; ++i) { const int flat = (tid + i * 512) * 4, row = flat >> 7, col = flat & 127; const f32x4 v = *(const f32x4*)(kp + flat); v2u o; o.x = pk2(v.x, v.y); o.y = pk2(v.z, v.w); *(LAS v2u*)(KLb + row * 136 + col) = o; }
#pragma unroll
                  for (int i = 0; i < 4; ++i) { const int flat = (tid + i * 512) * 4, row = flat >> 7, col = flat & 127; const f32x4 v = *(const f32x4*)(wq + (size_t)(kk0 + row) * 2048 + b16 * 128 + col); v2u o; o.x = pk2(v.x, v.y); o.y = pk2(v.z, v.w); *(LAS v2u*)(WLb + row * 136 + col) = o; }
                  __syncthreads();
                  const int c16 = lane & 15, quad = lane >> 4;
                  pg8::f32x4 acc[4];
#pragma unroll
                  for (int mt = 0; mt < 4; ++mt) acc[mt] = (pg8::f32x4){0.f, 0.f, 0.f, 0.f};
#pragma unroll
                  for (int ks = 0; ks < 4; ++ks) { const pg8::bf16x8 bq = *(const LAS pg8::bf16x8*)((LAS unsigned char*)KLb + (wave * 16 + c16) * 272 + ks * 64 + quad * 16);
#pragma unroll
                      for (int mt = 0; mt < 4; ++mt) { const pg8::bf16x8 aq = *(const LAS pg8::bf16x8*)((LAS unsigned char*)WLb + (mt * 16 + c16) * 272 + ks * 64 + quad * 16);
                          acc[mt] = __builtin_amdgcn_mfma_f32_16x16x32_bf16(aq, bq, acc[mt], 0, 0, 0); } }
                  bf16* op = Wqk_t + (size_t)l * 2048 * 2048 + (size_t)(b16 * 128 + wave * 16 + c16) * 2048 + kk0 + quad * 4;
#pragma unroll
                  for (int mt = 0; mt < 4; ++mt) { v2u o; o.x = pk2(acc[mt][0], acc[mt][1]); o.y = pk2(acc[mt][2], acc[mt][3]); *(v2u*)(op + mt * 16) = o; }
                  __syncthreads(); } }
            }
            __syncthreads();
            if (stage == 0) {
            { LAS float* scr = (LAS float*)(lds + wave * 16384);
              for (int it = gw; it < 2 * 16384; it += NGW) { const int l = it >> 14; int r = it & 16383;
                  if (r < 10752) { p0_transpose_item(args.in[2] + (size_t)l * 2048 * INC, 2048, INC, Win_t + (size_t)l * INC * 2048, scr, r, lane); continue; } r -= 10752;
                  if (r < 512) { p0_transpose_item(args.in[11] + (size_t)l * 1024 * 1024, 1024, 1024, Wglu_t + (size_t)l * 1024 * 1024, scr, r, lane); continue; } r -= 512;
                  if (r < 3072) { const int n = r >> 10; r &= 1023; p0_transpose_item(args.in[20] + (size_t)(l * 3 + n) * 1024 * 2048, 1024, 2048, Wbr_t + (size_t)(l * 3 + n) * 2048 * 1024, scr, r, lane); continue; } r -= 3072;
                  p0_transpose_item(args.in[21] + (size_t)l * 2048 * 2048, 2048, 2048, Wout_t + (size_t)l * 2048 * 2048, scr, r, lane); } }
            { const size_t gt = (size_t)bx * NTHR + tid;
              { f32x4 vnx[2][4];
                { const int tsel = gw >> 15, within = gw & 32767; const f32x4* src = (const f32x4*)((tsel ? args.in[26] : args.in[25]) + (size_t)within * 2048);
#pragma unroll
                  for (int j = 0; j < 2; ++j)
#pragma unroll
                      for (int q = 0; q < 4; ++q) vnx[j][q] = src[j * 256 + lane * 4 + q]; }
                for (int r = gw; r < 65536; r += NGW) { const int tsel = r >> 15, within = r & 32767;
                  f32x4 v[2][4]; float mx = 0.f;
#pragma unroll
                  for (int j = 0; j < 2; ++j)
#pragma unroll
                      for (int q = 0; q < 4; ++q) v[j][q] = vnx[j][q];
                  { const int rn = (r + NGW < 65536) ? r + NGW : r; const f32x4* srcn = (const f32x4*)(((rn >> 15) ? args.in[26] : args.in[25]) + (size_t)(rn & 32767) * 2048);
#pragma unroll
                    for (int j = 0; j < 2; ++j)
#pragma unroll
                        for (int q = 0; q < 4; ++q) vnx[j][q] = srcn[j * 256 + lane * 4 + q]; }
#pragma unroll
                  for (int j = 0; j < 2; ++j)
#pragma unroll
                      for (int q = 0; q < 4; ++q) mx = fmaxf(mx, fmaxf(fmaxf(fabsf(v[j][q].x), fabsf(v[j][q].y)), fmaxf(fabsf(v[j][q].z), fabsf(v[j][q].w))));
#pragma unroll
                  for (int o = 1; o < 64; o <<= 1) mx = fmaxf(mx, __shfl_xor(mx, o));
                  mx = fmaxf(mx, 1e-30f); const float qs = 440.f / mx;
#pragma unroll
                  for (int j = 0; j < 2; ++j) { v4u o;
#pragma unroll
                      for (int q = 0; q < 4; ++q) { int w = __builtin_amdgcn_cvt_pk_fp8_f32(v[j][q].x * qs, v[j][q].y * qs, 0, false); w = __builtin_amdgcn_cvt_pk_fp8_f32(v[j][q].z * qs, v[j][q].w * qs, w, true); o[q] = (unsigned)w; }
                      ((v4u*)((tsel ? P8V : P8U) + (size_t)within * 2048))[j * 64 + lane] = o; }
                  if (lane == 0) scl[r] = mx * (1.f / 440.f); } }
              if (gt < 8192) {
                  const int idx = (int)gt, lg = idx >> 6;
                  const float are = args.in[3][idx], aim = args.in[4][idx], dt = expf(args.in[10][lg]);
                  const float er = expf(are * dt), ang = aim * dt; const float abr = er * cosf(ang), abi = er * sinf(ang);
                  abar[idx * 2] = abr; abar[idx * 2 + 1] = abi;
                  const float nr = abr - 1.f, ni = abi, den = are * are + aim * aim; const float cr = (nr * are + ni * aim) / den, ci = (ni * are - nr * aim) / den;
                  for (int h = 0; h < 16; ++h) { const float br = args.in[5][(size_t)idx * 16 + h], bi = args.in[6][(size_t)idx * 16 + h];
                      const float bre = cr * br - ci * bi, bim = cr * bi + ci * br; const size_t kb = ((size_t)lg * 128 + 2 * (idx & 63)) * 16 + h;
                      bbt[kb] = (bf16)(pk2(bre, 0.f) & 0xffffu); bbt[kb + 16] = (bf16)(pk2(bim, 0.f) & 0xffffu); } } }
            }
            __syncthreads();
            }
            for (int m = gw; m < M; m += NGW) rms_row_to_bf16(args.in[0] + (size_t)m * D, args.in[1], hbuf + (size_t)m * D, lane);
#endif
        } else {
        const int l = (ph - 1) / 8, sub = (ph - 1) % 8;
        bf16* ys0 = ys; bf16* ys1 = ys + (size_t)M * 1024; bf16* ys2 = ys + (size_t)2 * M * 1024;
        if (sub == 0 && (PH_ON & 2)) {
            pg8::Gemm g{hbuf, Win_t + (size_t)l * INC * 2048, M, INC, 2048}; RangeOrder S; S.base.init(M, INC, G, 0); S.lo = 0; S.hi = (G == 256) ? 1280 : 1344; S.G2 = G; S.c2 = bx;
            EpiProj E{proj, sgst + (size_t)l * M * 32}; pg8::gemm_phase<EpiProj, RangeOrder, true, true>(lds, g, S, E);
        } else if (sub == 1 && (PH_ON & 4)) {
            for (int rp = 0; rp < ((REP_MIX & 1) ? 2 : 1); ++rp)
            for (int it = bx; it < 256; it += G) attn_item(it, l, proj, args.in[13] + l * 64, args.in[14] + l * 64, args.in[15] + l * 16, ys1, lds, tid);
            for (int rp = 0; rp < ((REP_MIX & 2) ? 2 : 1); ++rp)
            for (int it = bx; it < 512; it += G) sgu_item(it, l, proj, sgst + (size_t)l * M * 32, args.in[16], args.in[17], args.in[18], args.in[19], ys2, lds, tid, wave);
            for (int rp = 0; rp < ((REP_MIX & 4) ? 2 : 1); ++rp)
            for (int it = bx; it < 256; it += G) ssm_item<false>(it, l, proj, abar, bbt, args.in[7], args.in[8], args.in[9], send, yg, lds, tid, lane, wave);
        } else if (sub == 2 && (PH_ON & 8)) {
#if PROBE_P
            for (int rpp = 0; rpp < 4; ++rpp)
            for (int it = bx; it < 256; it += G) ssm_item<true>(it, l, proj, abar, bbt, args.in[7], args.in[8], args.in[9], send, yg, lds, tid, lane, wave, 0);
#endif
            for (int it = bx; it < 256; it += G) ssm_item<true>(it, l, proj, abar, bbt, args.in[7], args.in[8], args.in[9], send, yg, lds, tid, lane, wave);
        } else if (sub == 3 && (PH_ON & 16)) {
            pg8::Gemm g{yg, Wglu_t + (size_t)l * 1024 * 1024, M, 1024, 1024}; pg8::StaticOrder S; S.init(M, 1024, G, bx);
            EpiGlu E{yg, args.in[12] + l * 1024, ys0}; pg8::gemm_phase<EpiGlu, pg8::StaticOrder, true, true>(lds, g, S, E);
            if (G == 256) {
                pg8::Gemm g2{hbuf, Win_t + (size_t)l * INC * 2048, M, INC, 2048}; RangeOrder S2; S2.base.init(M, INC, G, 0); S2.lo = 1280; S2.hi = 1344; S2.G2 = G; S2.c2 = (bx + 128) & 255;
                EpiProj E2{proj, sgst + (size_t)l * M * 32}; pg8::gemm_phase<EpiProj, RangeOrder, true, true>(lds, g2, S2, E2); }
        } else if (sub == 4 && (PH_ON & 32)) {
            pg8::Gemm g{ys, Wbr_t + (size_t)l * 3 * 2048 * 1024, 3 * M, 3 * 2048, 1024}; BranchOrder S{G, bx};
            EpiBranch E{proj, merged}; pg8::gemm_phase<EpiBranch, BranchOrder, true, true>(lds, g, S, E);
        } else if (sub == 5 && (PH_ON & 64)) {
            pg8::Gemm g{merged, Wout_t + (size_t)l * 2048 * 2048, M, 2048, 2048}; pg8::StaticOrder S; S.init(M, 2048, G, bx);
            EpiResidNorm E{l == 0 ? args.in[0] : (const float*)args.out, args.out, args.in[22] + l * D, xnbuf, rowss + (size_t)l * M * 32}; pg8::gemm_phase<EpiResidNorm, pg8::StaticOrder, true, true>(lds, g, S, E);
        } else if (sub == 6 && (PH_ON & 256)) {
            pg8::Gemm g{xnbuf, Wqk_t + (size_t)l * 2048 * 2048, M, 2048, 2048}; pg8::StaticOrder S; S.init(M, 2048, G, bx);
            EpiScoreF32 E{scores, rowss + (size_t)l * M * 32}; pg8::gemm_phase<EpiScoreF32, pg8::StaticOrder, true, true>(lds, g, S, E);
        } else if (PH_ON & 512) {
            const bool dry = rep + 1 < nrep;
            peer_phase(l, scores, xnbuf, P8U, P8V, scl, rowss + (size_t)l * M * 32, args.out, dry ? mtmp : args.out, args.in[1] + (l + 1 < DEPTH ? (l + 1) * D : 0), dry ? merged : hbuf, l + 1 < DEPTH, lds, lane, wave, gw, NGW, (unsigned*)ws + 4096 + 64 * xbar.x, bst[0] ? bst[0] : 1u);
        }
        }
        __syncthreads();
        }
    }
}

extern "C" void kernel_launch(void* const* d_in, const int* in_sizes, int n_in, void* d_out, int out_size, void* d_ws, size_t ws_size, hipStream_t stream) {
    static int grid = 0;
    if (grid == 0) {
        if (n_in != 27 || out_size != M * D || ws_size < WS_END) { fprintf(stderr, "kernel_launch: unexpected shapes (n_in %d out %d ws %zu)\n", n_in, out_size, ws_size); grid = -1; return; }
        int dev = 0, cus = 0, per_cu = 0;
        (void)hipGetDevice(&dev); (void)hipDeviceGetAttribute(&cus, hipDeviceAttributeMultiprocessorCount, dev);
        if (hipFuncSetAttribute((const void*)hybrid_fwd, hipFuncAttributeMaxDynamicSharedMemorySize, LDS_BYTES) != hipSuccess) { fprintf(stderr, "kernel_launch: hipFuncSetAttribute failed\n"); grid = -1; return; }
        if (hipOccupancyMaxActiveBlocksPerMultiprocessor(&per_cu, (const void*)hybrid_fwd, NTHR, LDS_BYTES) != hipSuccess || per_cu < 1) { fprintf(stderr, "kernel_launch: occupancy query failed (%d)\n", per_cu); (void)hipGetLastError(); grid = -1; return; }
        grid = cus * per_cu;
    }
    if (grid < 0) return;
    Args a{};
    for (int i = 0; i < 27; ++i) a.in[i] = (const float*)d_in[i];
    a.out = (float*)d_out; a.ws = (unsigned char*)d_ws;
#if N_LAUNCH_MODE == 1
    a.ph_lo = 0; a.ph_hi = NPHASE;
    if (hipMemsetAsync(d_ws, 0, 131072, stream) != hipSuccess) { fprintf(stderr, "kernel_launch: hipMemsetAsync failed\n"); return; }
    void* kargs[] = {&a};
    hipError_t e = hipLaunchCooperativeKernel((const void*)hybrid_fwd, dim3(grid), dim3(NTHR), kargs, LDS_BYTES, stream);
    if (e != hipSuccess) fprintf(stderr, "kernel_launch: cooperative launch failed: %s (grid %d)\n", hipGetErrorString(e), grid);
#else
    (void)hipMemsetAsync(d_ws, 0, 131072, stream);
    for (int ph = 0; ph < NPHASE; ++ph) { a.ph_lo = ph; a.ph_hi = ph + 1; hipLaunchKernelGGL(hybrid_fwd, dim3(grid), dim3(NTHR), LDS_BYTES, stream, a); }
#endif
}
```
